# Optimizing an MI355X kernel written in HIP

```python
import jax, jax.numpy as jnp
from jax import lax
import numpy as np

D_MODEL = 1024
BATCH = 4
SEQ = 4096
DEPTH = 4
DEC_BATCH = 2
DEC_SEQ = 16384
PAST_LEN = 128

N_BRANCHES = 4
BRANCH_WIDTH = D_MODEL // 2
HEAD_DIM = 128
N_HEADS_BRANCH = BRANCH_WIDTH // HEAD_DIM
DILATION_GROUPS = ((128, 1), (512, 4), (2048, 16))
N_DIL = len(DILATION_GROUPS)
A_HEADS_TOTAL = N_DIL * N_HEADS_BRANCH
A_QKV_WIDTH = A_HEADS_TOTAL * HEAD_DIM
REL_BUCKETS = 32
REL_MAX_DIST = 1024
FNET_GROUPS = 4
FNET_GROUP_WIDTH = BRANCH_WIDTH // FNET_GROUPS
MLSTM_CHUNK = 64
MLSTM_CONV = 5
MLSTM_GATES = 2 * 2 * N_HEADS_BRANCH
N_MEM = 256
IN_WIDTH = (3 * A_QKV_WIDTH + BRANCH_WIDTH + 4 * BRANCH_WIDTH + MLSTM_GATES + BRANCH_WIDTH
            + N_BRANCHES * BRANCH_WIDTH + N_BRANCHES * D_MODEL)
EPS = 1e-6
NEG = -1e30

kernel_name = "hybrid_dilated_fnet_mlstm_encoder"


def rms_norm(x, g):
    xf = x.astype(jnp.float32)
    y = xf * lax.rsqrt(jnp.mean(xf * xf, axis=-1, keepdims=True) + EPS)
    return (y * g.astype(jnp.float32)).astype(x.dtype)


def t5_bucket(rel):
    nb = REL_BUCKETS // 2
    max_exact = nb // 2
    ret = (rel > 0).astype(np.int32) * nb
    n = np.abs(rel)
    large = max_exact + (np.log(np.maximum(n, 1) / max_exact) / np.log(REL_MAX_DIST / max_exact)
                         * (nb - max_exact)).astype(np.int32)
    large = np.minimum(large, nb - 1)
    return (ret + np.where(n < max_exact, n, large)).astype(np.int32)


def band_bias(rel_bias_heads, dilation, half):
    rel = np.arange(3 * half)[None, :] - half - np.arange(half)[:, None]
    idx = t5_bucket(dilation * rel)
    return jnp.transpose(rel_bias_heads[idx], (2, 0, 1))


def dilated_window_attention(q, k, v, dilation, half, bias):
    B, L, H, C = q.shape
    M = L // dilation
    nb = -(-M // half)
    Mp = nb * half

    def to_sub(t):
        return t.reshape(B, M, dilation, H, C).transpose(0, 2, 3, 1, 4)

    def key_windows(t):
        tp = jnp.pad(t, ((0, 0), (0, 0), (0, 0), (half, Mp - M + half), (0, 0)))
        tp = tp.reshape(B, dilation, H, nb + 2, half, C)
        return jnp.concatenate([tp[:, :, :, 0:nb], tp[:, :, :, 1:nb + 1], tp[:, :, :, 2:nb + 2]], axis=4)

    qb = jnp.pad(to_sub(q), ((0, 0), (0, 0), (0, 0), (0, Mp - M), (0, 0))).reshape(B, dilation, H, nb, half, C)
    kw = key_windows(to_sub(k))
    vw = key_windows(to_sub(v))
    s = jnp.einsum('brhnqc,brhnkc->brhnqk', qb, kw).astype(jnp.float32) * (C ** -0.5)
    s = s + bias[None, None, :, None].astype(jnp.float32)
    rel = np.arange(3 * half)[None, :] - half - np.arange(half)[:, None]
    band = np.abs(rel) <= half
    kidx = np.arange(nb)[:, None] * half - half + np.arange(3 * half)[None, :]
    valid = (kidx >= 0) & (kidx < M)
    mask = jnp.asarray(band[None] & valid[:, None, :])
    s = jnp.where(mask, s, NEG)
    lse = jax.nn.logsumexp(s, axis=-1)
    p = jnp.exp(s - lse[..., None])
    o = jnp.einsum('brhnqk,brhnkc->brhnqc', p.astype(vw.dtype), vw)
    o = o.reshape(B, dilation, H, Mp, C)[:, :, :, :M].transpose(0, 3, 1, 2, 4).reshape(B, L, H, C)
    lse = lse.reshape(B, dilation, H, Mp)[..., :M].transpose(0, 3, 1, 2).reshape(B, L, H)
    return o, lse


def centred_conv(x, w):
    K = w.shape[0]
    pad = K // 2
    L = x.shape[1]
    xp = jnp.pad(x, ((0, 0), (pad, pad), (0, 0)))
    return sum(xp[:, j:j + L] * w[j] for j in range(K))


def mlstm_chunked(q, k, v, i_pre, f_pre):
    B, H, L, dh = q.shape
    T = MLSTM_CHUNK
    N = L // T
    q = q.reshape(B, H, N, T, dh) * (dh ** -0.5)
    k = k.reshape(B, H, N, T, dh)
    v = v.reshape(B, H, N, T, dh)
    ig = i_pre.reshape(B, H, N, T)
    b = jnp.cumsum(jax.nn.log_sigmoid(f_pre).reshape(B, H, N, T), axis=-1)
    g = b[..., -1]
    causal = jnp.tril(jnp.ones((T, T), dtype=bool))
    logd = jnp.where(causal, b[..., :, None] - b[..., None, :] + ig[..., None, :], NEG)
    a = g[..., None] - b + ig
    ma = jnp.max(a, axis=-1)
    wa = jnp.exp(a - ma[..., None])
    c_loc = jnp.einsum('bhnt,bhntd,bhnte->bhnde', wa, k, v)
    n_loc = jnp.einsum('bhnt,bhntd->bhnd', wa, k)

    def step(carry, inp):
        c, n, m = carry
        g_c, ma_c, c_l, n_l = inp
        m_new = jnp.maximum(g_c + m, ma_c)
        s_old = jnp.exp(g_c + m - m_new)
        s_new = jnp.exp(ma_c - m_new)
        c_new = s_old[..., None, None] * c + s_new[..., None, None] * c_l
        n_new = s_old[..., None] * n + s_new[..., None] * n_l
        return (c_new, n_new, m_new), (c, n, m)

    init = (jnp.zeros((B, H, dh, dh), jnp.float32), jnp.zeros((B, H, dh), jnp.float32),
            jnp.zeros((B, H), jnp.float32))
    xs = (jnp.moveaxis(g, 2, 0), jnp.moveaxis(ma, 2, 0), jnp.moveaxis(c_loc, 2, 0), jnp.moveaxis(n_loc, 2, 0))
    _, (c_prev, n_prev, m_prev) = lax.scan(step, init, xs)
    c_prev = jnp.moveaxis(c_prev, 0, 2)
    n_prev = jnp.moveaxis(n_prev, 0, 2)
    m_prev = jnp.moveaxis(m_prev, 0, 2)
    inter = b + m_prev[..., None]
    m_t = jnp.maximum(inter, jnp.max(logd, axis=-1))
    w_intra = jnp.exp(logd - m_t[..., None])
    w_inter = jnp.exp(inter - m_t)
    sqk = w_intra * jnp.einsum('bhntd,bhnsd->bhnts', q, k)
    num = (w_inter[..., None] * jnp.einsum('bhntd,bhnde->bhnte', q, c_prev)
           + jnp.einsum('bhnts,bhnse->bhnte', sqk, v))
    den = w_inter * jnp.einsum('bhntd,bhnd->bhnt', q, n_prev) + jnp.sum(sqk, axis=-1)
    h = num / jnp.maximum(jnp.abs(den), jnp.exp(-m_t))[..., None]
    return h.reshape(B, H, L, dh)


def encoder_layer(x, mem, rel_bias, norm_pre, w_in, conv_qk, gate_bias, head_gain, mem_norm,
                  w_mem_kv, w_branch, w_out, norm_post):
    B, L, _ = x.shape
    H, dh, W = N_HEADS_BRANCH, HEAD_DIM, BRANCH_WIDTH
    h = rms_norm(x, norm_pre)
    z = h @ w_in
    widths = [A_QKV_WIDTH] * 3 + [W] + [W] * 4 + [MLSTM_GATES, W, N_BRANCHES * W, N_BRANCHES * D_MODEL]
    splits = np.cumsum(widths)[:-1].tolist()
    qa, ka, va, xb, qc, kc, vc, oc, gc, qd, gp, mg = jnp.split(z, splits, axis=-1)

    qa = qa.reshape(B, L, N_DIL, H, dh)
    ka = ka.reshape(B, L, N_DIL, H, dh)
    va = va.reshape(B, L, N_DIL, H, dh)
    outs, lses = [], []
    for gi, (window, dilation) in enumerate(DILATION_GROUPS):
        half = window // (2 * dilation)
        bias = band_bias(rel_bias[:, gi * H:(gi + 1) * H], dilation, half)
        o, l = dilated_window_attention(qa[:, :, gi], ka[:, :, gi], va[:, :, gi], dilation, half, bias)
        outs.append(o.astype(jnp.float32))
        lses.append(l)
    wgt = jax.nn.softmax(jnp.stack(lses, axis=0), axis=0)
    ya = jnp.einsum('gblh,gblhc->blhc', wgt, jnp.stack(outs, axis=0)).reshape(B, L, W)

    xb4 = xb.reshape(B, L, FNET_GROUPS, FNET_GROUP_WIDTH).astype(jnp.float32)
    yb = jnp.fft.fft2(xb4, axes=(1, 3), norm="ortho").real.reshape(B, L, W)

    qm = jax.nn.silu(centred_conv(qc, conv_qk[:, :W])).astype(jnp.float32)
    km = jax.nn.silu(centred_conv(kc, conv_qk[:, W:])).astype(jnp.float32)
    to_heads = lambda t: t.astype(jnp.float32).reshape(B, L, H, dh).transpose(0, 2, 1, 3)
    qm, km, vm = to_heads(qm), to_heads(km), to_heads(vc)
    gates = gc.astype(jnp.float32).reshape(B, L, 2, 2, H) + gate_bias.astype(jnp.float32)
    gates = gates.transpose(2, 3, 0, 4, 1)
    h_fwd = mlstm_chunked(qm, km, vm, gates[0, 0], gates[0, 1])
    flip = lambda t: jnp.flip(t, axis=2)
    h_bwd = flip(mlstm_chunked(flip(qm), flip(km), flip(vm), flip(gates[1, 0]), flip(gates[1, 1])))
    hc = (h_fwd + h_bwd).transpose(0, 2, 1, 3)
    hc = jax.nn.sigmoid(oc.astype(jnp.float32)).reshape(B, L, H, dh) * hc
    mu = jnp.mean(hc, axis=-1, keepdims=True)
    var = jnp.mean(jnp.square(hc - mu), axis=-1, keepdims=True)
    yc = ((hc - mu) * lax.rsqrt(var + EPS) * head_gain.astype(jnp.float32).reshape(H, dh)).reshape(B, L, W)

    kv = (rms_norm(mem, mem_norm) @ w_mem_kv).reshape(B, N_MEM, 2, H, dh)
    qd4 = qd.reshape(B, L, H, dh)
    s = jnp.einsum('blhc,bmhc->bhlm', qd4, kv[:, :, 0]).astype(jnp.float32) * (dh ** -0.5)
    p = jax.nn.softmax(s, axis=-1)
    yd = jnp.einsum('bhlm,bmhc->blhc', p.astype(kv.dtype), kv[:, :, 1]).reshape(B, L, W)

    branches = jnp.stack([ya, yb, yc, yd], axis=2).astype(x.dtype)
    gated = branches * jax.nn.silu(gp).reshape(B, L, N_BRANCHES, W)
    proj = jnp.einsum('blgc,gcd->blgd', gated, w_branch)
    merged = jnp.einsum('blgd,blgd->bld', jax.nn.sigmoid(mg).reshape(B, L, N_BRANCHES, D_MODEL), proj)
    out = merged @ w_out
    return x + rms_norm(out, norm_post)


def encoder_trunk(x, mem, rel_bias, norm_pre, w_in, conv_qk, mlstm_gate_bias, mlstm_head_gain,
                  mem_norm, w_mem_kv, w_branch, w_out, norm_post):
    for layer in range(DEPTH):
        x = encoder_layer(x, mem, rel_bias, norm_pre[layer], w_in[layer], conv_qk[layer],
                          mlstm_gate_bias[layer], mlstm_head_gain[layer], mem_norm[layer],
                          w_mem_kv[layer], w_branch[layer], w_out[layer], norm_post[layer])
    return x


def setup_inputs(seed: int = 0) -> dict:
    key = jax.random.key(seed)
    ks = jax.random.split(key, 20)
    nrm = lambda k, shape, scale: jax.random.normal(k, shape, jnp.float32) * scale
    H = N_HEADS_BRANCH
    i_bias = nrm(ks[10], (DEPTH, 2, 1, H), 0.1)
    f_bias = jnp.linspace(3.0, 6.0, H, dtype=jnp.float32)[None, None, None, :] + nrm(ks[11], (DEPTH, 2, 1, H), 0.1)
    return {
        "x_prompt": nrm(ks[0], (BATCH, SEQ, D_MODEL), 1.0),
        "x_sample": nrm(ks[1], (DEC_BATCH, DEC_SEQ, D_MODEL), 1.0),
        "mem_prompt": nrm(ks[2], (BATCH, N_MEM, D_MODEL), 1.0),
        "mem_sample": nrm(ks[3], (DEC_BATCH, N_MEM, D_MODEL), 1.0),
        "rel_bias": nrm(ks[4], (REL_BUCKETS, A_HEADS_TOTAL), 0.5),
        "norm_pre": 1.0 + nrm(ks[5], (DEPTH, D_MODEL), 0.1),
        "w_in": nrm(ks[6], (DEPTH, D_MODEL, IN_WIDTH), D_MODEL ** -0.5),
        "conv_qk": nrm(ks[7], (DEPTH, MLSTM_CONV, 2 * BRANCH_WIDTH), MLSTM_CONV ** -0.5),
        "mlstm_gate_bias": jnp.concatenate([i_bias, f_bias], axis=2),
        "mlstm_head_gain": 1.0 + nrm(ks[8], (DEPTH, BRANCH_WIDTH), 0.1),
        "mem_norm": 1.0 + nrm(ks[9], (DEPTH, D_MODEL), 0.1),
        "w_mem_kv": nrm(ks[12], (DEPTH, D_MODEL, 2 * BRANCH_WIDTH), D_MODEL ** -0.5),
        "w_branch": nrm(ks[13], (DEPTH, N_BRANCHES, BRANCH_WIDTH, D_MODEL), BRANCH_WIDTH ** -0.5),
        "w_out": nrm(ks[14], (DEPTH, D_MODEL, D_MODEL), D_MODEL ** -0.5),
        "norm_post": 1.0 + nrm(ks[15], (DEPTH, D_MODEL), 0.1),
    }


def reference(x_prompt, x_sample, mem_prompt, mem_sample, rel_bias, norm_pre, w_in, conv_qk,
              mlstm_gate_bias, mlstm_head_gain, mem_norm, w_mem_kv, w_branch, w_out, norm_post):
    y_prompt = encoder_trunk(x_prompt, mem_prompt, rel_bias, norm_pre, w_in, conv_qk, mlstm_gate_bias,
                             mlstm_head_gain, mem_norm, w_mem_kv, w_branch, w_out, norm_post)
    y_sample = encoder_trunk(x_sample, mem_sample, rel_bias, norm_pre, w_in, conv_qk, mlstm_gate_bias,
                             mlstm_head_gain, mem_norm, w_mem_kv, w_branch, w_out, norm_post)
    return (y_prompt, y_sample)
```

```cpp
#include <hip/hip_runtime.h>
#include <hip/hip_cooperative_groups.h>
#include <cstdio>
#include <cstring>
#include <cmath>
namespace cg = cooperative_groups;

#ifndef MK_COOP
#define MK_COOP 1
#endif
#ifndef PROBE_UNITS
#define PROBE_UNITS 15
#endif
#ifndef PROBE_REPEAT
#define PROBE_REPEAT 0
#endif

typedef unsigned short u16;
using bf16x8 = __attribute__((ext_vector_type(8))) short;
using s16x4 = __attribute__((ext_vector_type(4))) short;
using f32x4 = __attribute__((ext_vector_type(4))) float;
using u32x4 = __attribute__((ext_vector_type(4))) unsigned;
using u32x2 = __attribute__((ext_vector_type(2))) unsigned;
#define DI __device__ __forceinline__

constexpr int DM = 1024;
constexpr int LDZ = 14080;
constexpr int NORIG = 13840;
constexpr int C_QA = 0, C_KA = 1536, C_VA = 3072, C_XB = 4608, C_QC = 5120, C_KC = 5632, C_VC = 6144, C_OC = 6656,
              C_QD = 7168, C_GP = 7680, C_MG = 9728, C_GC = 13824;
constexpr int LDH = 1088;
constexpr int LDG = 2112;
constexpr int MTOK = 16384;
constexpr float EPSV = 1e-6f;
constexpr float QSCALE = 0.08838834764831845f;
constexpr int SMEM_HALF = 75776;
constexpr int SMEM_BYTES = 2 * SMEM_HALF;

constexpr size_t OFF_WIN = 0;
constexpr size_t OFF_WB = OFF_WIN + (size_t)4 * LDZ * LDH * 2;
constexpr size_t OFF_WO = OFF_WB + (size_t)4 * 1024 * LDG * 2;
constexpr size_t OFF_KVK = OFF_WO + (size_t)4 * 1024 * LDH * 2;
constexpr size_t OFF_KVV = OFF_KVK + 6291456;
constexpr size_t OFF_DFT = OFF_KVV + 6291456;
constexpr size_t OFF_H = OFF_DFT + 131072;
constexpr size_t OFF_GATED = OFF_H + (size_t)16384 * LDH * 2;
constexpr size_t OFF_LSE = OFF_GATED + (size_t)16384 * LDG * 2;
constexpr size_t OFF_OUT = OFF_LSE + 786432;
constexpr size_t OFF_CS = OFF_OUT + 67108864;
constexpr size_t OFF_NS = OFF_CS + 67108864;
constexpr size_t OFF_SC = OFF_NS + 1048576;
constexpr size_t OFF_BAR = OFF_SC + 32768;
constexpr size_t OFF_Z = OFF_SC + 65536;
constexpr size_t OFF_WKV = OFF_Z;
constexpr size_t OFF_HM = OFF_Z + (size_t)4 * 1024 * LDH * 2;
constexpr size_t WS_NEED = OFF_Z + (size_t)16384 * LDZ * 2;

struct Params {
  const float *x_prompt, *x_sample, *mem_prompt, *mem_sample, *rel_bias, *norm_pre, *w_in, *conv_qk, *gate_bias,
      *head_gain, *mem_norm, *w_mem_kv, *w_branch, *w_out, *norm_post;
  float* out;
  unsigned char* ws;
};
struct Bucket { unsigned char b[3][136]; };

DI int TIDX() { int t = threadIdx.x & 255; asm volatile("" : "+v"(t)); return t; }
DI int HALF_ID() { return __builtin_amdgcn_readfirstlane((int)(threadIdx.x >> 8)); }
DI int VB() { return (int)blockIdx.x * 2 + HALF_ID(); }
DI int VG() { return (int)gridDim.x * 2; }
DI u16 f2bf(float x) { unsigned u = __float_as_uint(x); u += 0x7fffu + ((u >> 16) & 1u); return (u16)(u >> 16); }
DI float bf2f(u16 h) { return __uint_as_float(((unsigned)h) << 16); }
DI float bflo(unsigned u) { return __uint_as_float(u << 16); }
DI float bfhi(unsigned u) { return __uint_as_float(u & 0xffff0000u); }
DI unsigned pack2(float a, float b) { return (unsigned)f2bf(a) | ((unsigned)f2bf(b) << 16); }
DI f32x4 mfma16(bf16x8 a, bf16x8 b, f32x4 c) { return __builtin_amdgcn_mfma_f32_16x16x32_bf16(a, b, c, 0, 0, 0); }
DI bf16x8 ldfrag(const u16* p) { return *reinterpret_cast<const bf16x8*>(p); }
DI float wsum(float v) { for (int o = 32; o; o >>= 1) v += __shfl_xor(v, o); return v; }
DI float wmaxr(float v) { for (int o = 32; o; o >>= 1) v = fmaxf(v, __shfl_xor(v, o)); return v; }
DI float sigmoidf_(float x) { return 1.f / (1.f + __expf(-x)); }
DI float siluf_(float x) { return x / (1.f + __expf(-x)); }
DI float logsigf_(float x) { return fminf(x, 0.f) - log1pf(__expf(-fabsf(x))); }
DI void unpack8(u32x4 v, float (&f)[8]) {
  f[0] = bflo(v.x); f[1] = bfhi(v.x); f[2] = bflo(v.y); f[3] = bfhi(v.y);
  f[4] = bflo(v.z); f[5] = bfhi(v.z); f[6] = bflo(v.w); f[7] = bfhi(v.w);
}
DI bf16x8 negfrag(bf16x8 a) {
  bf16x8 r;
#pragma unroll
  for (int j = 0; j < 8; ++j) r[j] = (short)(a[j] ^ (short)0x8000);
  return r;
}


#define XB_TMO      128
#define XB_XCNT(j)  (256  + 64 * (j))
#define XB_XSUB(j)  (1280 + 64 * (j))
#define XB_XGEN(j)  (2304 + 64 * (j))
#define XB_TOP      3328
#define XB_TOPGEN   3392
#define XCD_BAR_WORDS 3456
#define XB_SPIN_CAP (1u << 22)
#define LAS __attribute__((address_space(3)))
DI unsigned xb_ld(unsigned* p) { return __hip_atomic_load(p, __ATOMIC_RELAXED, __HIP_MEMORY_SCOPE_AGENT); }
DI unsigned xb_add(unsigned* p, unsigned v) { return __hip_atomic_fetch_add(p, v, __ATOMIC_RELAXED, __HIP_MEMORY_SCOPE_AGENT); }
DI unsigned xb_xcc_id() { return (unsigned)__builtin_amdgcn_s_getreg((3 << 11) | 20) & 0xFu; }
#define XB_SPIN(cond, bar) do { unsigned _sp = 0; while (cond) { __builtin_amdgcn_s_sleep(1); \
    if ((++_sp & 255u) == 0u) { if (xb_ld(&(bar)[XB_TMO])) break; if (_sp > XB_SPIN_CAP) { atomicAdd(&(bar)[XB_TMO], 1u); break; } } } } while (0)
struct XcdBarrier { unsigned* bar; unsigned x; volatile LAS unsigned* st; };
DI XcdBarrier xcd_barrier_post(unsigned* bar, volatile LAS unsigned* st) {
  XcdBarrier b; b.bar = bar; b.x = xb_xcc_id(); b.st = st;
  if (threadIdx.x == 0) (void)xb_add(&bar[XB_XCNT(b.x)], 1u);
  return b;
}
DI void xcd_barrier_complete(unsigned* bar, unsigned x, unsigned& nloc, unsigned& nx) {
  const unsigned G = gridDim.x * gridDim.y * gridDim.z;
  unsigned sum, cnt, mine, sp = 0u;
  for (;;) {
    sum = 0u; cnt = 0u; mine = 0u;
#pragma unroll
    for (unsigned j = 0; j < 16; ++j) { const unsigned c = xb_ld(&bar[XB_XCNT(j)]); sum += c; cnt += (c > 0u) ? 1u : 0u; mine = (j == x) ? c : mine; }
    if (sum == G) break;
    __builtin_amdgcn_s_sleep(1);
    if ((++sp & 255u) == 0u) { if (xb_ld(&bar[XB_TMO])) break; if (sp > XB_SPIN_CAP) { atomicAdd(&bar[XB_TMO], 1u); break; } }
  }
  nloc = mine > 0u ? mine : 1u; nx = cnt > 0u ? cnt : 1u;
}
DI void xcd_barrier(const XcdBarrier& b) {
  asm volatile("s_waitcnt vmcnt(0)" ::: "memory");
  __syncthreads();
  if (threadIdx.x == 0) {
    unsigned* bar = b.bar;
    __builtin_amdgcn_s_waitcnt(0);
    unsigned nloc = b.st[0], nx = b.st[1];
    if (nloc == 0u) { xcd_barrier_complete(bar, b.x, nloc, nx); b.st[0] = nloc; b.st[1] = nx; }
    const unsigned old = xb_add(&bar[XB_XSUB(b.x)], 1u);
    const unsigned gen = old / nloc;
    if (old + 1u == (gen + 1u) * nloc) {
      __builtin_amdgcn_fence(__ATOMIC_RELEASE, "agent");
      asm volatile("s_waitcnt vmcnt(0)" ::: "memory");
      const unsigned og = xb_add(&bar[XB_TOP], 1u);
      const unsigned tg = og / nx;
      if (og + 1u == (tg + 1u) * nx) xb_add(&bar[XB_TOPGEN], 1u);
      else XB_SPIN(xb_ld(&bar[XB_TOPGEN]) == tg, bar);
      __builtin_amdgcn_fence(__ATOMIC_ACQUIRE, "agent");
      xb_add(&bar[XB_XGEN(b.x)], 1u);
      asm volatile("s_waitcnt vmcnt(0)" ::: "memory");
    } else {
      XB_SPIN(xb_ld(&bar[XB_XGEN(b.x)]) == gen, bar);
      __builtin_amdgcn_fence(__ATOMIC_ACQUIRE, "agent");
      asm volatile("s_waitcnt vmcnt(0)" ::: "memory");
    }
  }
  __syncthreads();
}

struct SB {
  const float* xin; float* xout; int B, L, memb, N1;
};
DI SB get_sb(const Params& p, int sb) {
  SB s;
  if (sb < 2) { s.xin = p.x_sample + (size_t)sb * MTOK * DM; s.xout = p.out + (size_t)(MTOK + sb * MTOK) * DM; s.B = 1; s.L = 16384; s.memb = 4 + sb; s.N1 = 128; }
  else { s.xin = p.x_prompt; s.xout = p.out; s.B = 4; s.L = 4096; s.memb = 0; s.N1 = 64; }
  return s;
}

#define G_LOAD(RA, RB, K0) _Pragma("unroll") for (int i = 0; i < 4; ++i) { \
    RA[i] = *(const u32x4*)(A + (size_t)(lr + 32 * i) * lda + (K0) + lc); RB[i] = *(const u32x4*)(Bt + (size_t)(lr + 32 * i) * ldb + (K0) + lc); }
#define G_WRITE(RA, RB, BUF) _Pragma("unroll") for (int i = 0; i < 4; ++i) { \
    *(u32x4*)(sA + (BUF) * 8192 + (lr + 32 * i) * 64 + wsw) = RA[i]; *(u32x4*)(sB + (BUF) * 8192 + (lr + 32 * i) * 64 + wsw) = RB[i]; }
#define G_COMPUTE(BUF) { \
    const u16* a0 = sA + (BUF) * 8192 + (wm * 64 + (lane & 15)) * 64; \
    const u16* b0 = sB + (BUF) * 8192 + (wn * 64 + (lane & 15)) * 64; \
    if (PIPE) { \
      bf16x8 a[2][4], b[2][4]; \
      _Pragma("unroll") for (int t = 0; t < 4; ++t) { a[0][t] = ldfrag(a0 + t * 1024 + rs0); b[0][t] = ldfrag(b0 + t * 1024 + rs0); } \
      _Pragma("unroll") for (int t = 0; t < 4; ++t) { a[1][t] = ldfrag(a0 + t * 1024 + rs1); b[1][t] = ldfrag(b0 + t * 1024 + rs1); } \
      __builtin_amdgcn_sched_barrier(0); \
      _Pragma("unroll") for (int ks = 0; ks < 2; ++ks) \
        _Pragma("unroll") for (int mt = 0; mt < 4; ++mt) _Pragma("unroll") for (int nt = 0; nt < 4; ++nt) acc[mt][nt] = mfma16(b[ks][nt], a[ks][mt], acc[mt][nt]); \
      __builtin_amdgcn_sched_barrier(0); \
    } else { \
      _Pragma("unroll") for (int ks = 0; ks < 2; ++ks) { \
        bf16x8 a[4], b[4]; \
        _Pragma("unroll") for (int t = 0; t < 4; ++t) { a[t] = ldfrag(a0 + t * 1024 + (ks ? rs1 : rs0)); b[t] = ldfrag(b0 + t * 1024 + (ks ? rs1 : rs0)); } \
        _Pragma("unroll") for (int mt = 0; mt < 4; ++mt) _Pragma("unroll") for (int nt = 0; nt < 4; ++nt) acc[mt][nt] = mfma16(b[nt], a[mt], acc[mt][nt]); } } }
template <bool DEEP, bool PIPE>
DI void gemm_acc(f32x4 (&acc)[4][4], const u16* __restrict__ A, int lda, const u16* __restrict__ Bt, int ldb, int nk, u16* smem) {
  const int tid = TIDX(), lane = tid & 63, w = tid >> 6, wm = w >> 1, wn = w & 1;
  u16* sA = smem;
  u16* sB = smem + 2 * 8192;
  const int lr = tid >> 3, lc = (tid & 7) * 8;
  const int wsw = ((tid & 7) ^ ((lr >> 1) & 7)) * 8;
  const int rg = (lane & 15) >> 1, rq = lane >> 4;
  const int rs0 = (((rg >> 2) * 4) + (rq ^ (rg & 3))) * 8;
  const int rs1 = ((((rg >> 2) ^ 1) * 4) + (rq ^ (rg & 3))) * 8;
  u32x4 r0a[4], r0b[4];
  G_LOAD(r0a, r0b, 0)
  if (DEEP) {
    u32x4 r1a[4], r1b[4];
    G_LOAD(r1a, r1b, 64)
    __syncthreads();
    G_WRITE(r0a, r0b, 0)
    __syncthreads();
    if (2 < nk) { G_LOAD(r0a, r0b, 128) }
#pragma unroll 1
    for (int kt = 0; kt < nk; kt += 2) {
      G_COMPUTE(0)
      if (kt + 1 < nk) { G_WRITE(r1a, r1b, 1) }
      if (kt + 3 < nk) { G_LOAD(r1a, r1b, (kt + 3) * 64) }
      __syncthreads();
      if (kt + 1 >= nk) break;
      G_COMPUTE(1)
      if (kt + 2 < nk) { G_WRITE(r0a, r0b, 0) }
      if (kt + 4 < nk) { G_LOAD(r0a, r0b, (kt + 4) * 64) }
      __syncthreads();
    }
  } else {
    __syncthreads();
    G_WRITE(r0a, r0b, 0)
    __syncthreads();
#pragma unroll 1
    for (int kt = 0; kt < nk; ++kt) {
      const int buf = kt & 1;
      if (kt + 1 < nk) { G_LOAD(r0a, r0b, (kt + 1) * 64) }
      G_COMPUTE(buf)
      if (kt + 1 < nk) { G_WRITE(r0a, r0b, buf ^ 1) }
      __syncthreads();
    }
  }
}

#define G_READ(F_A, F_B, BUF, RS) { \
    const u16* a0 = sA + (BUF) * 8192 + (wm * 64 + (lane & 15)) * 64 + (RS); \
    const u16* b0 = sB + (BUF) * 8192 + (wn * 64 + (lane & 15)) * 64 + (RS); \
    _Pragma("unroll") for (int t = 0; t < 4; ++t) { F_A[t] = ldfrag(a0 + t * 1024); F_B[t] = ldfrag(b0 + t * 1024); } }
#define G_MMA(F_A, F_B) { \
    _Pragma("unroll") for (int mt = 0; mt < 4; ++mt) _Pragma("unroll") for (int nt = 0; nt < 4; ++nt) acc[mt][nt] = mfma16(F_B[nt], F_A[mt], acc[mt][nt]); }
DI void gemm_acc_sp(f32x4 (&acc)[4][4], const u16* __restrict__ A, int lda, const u16* __restrict__ Bt, int ldb, int nk, u16* smem) {
  const int tid = TIDX(), lane = tid & 63, w = tid >> 6, wm = w >> 1, wn = w & 1;
  u16* sA = smem;
  u16* sB = smem + 2 * 8192;
  const int lr = tid >> 3, lc = (tid & 7) * 8;
  const int wsw = ((tid & 7) ^ ((lr >> 1) & 7)) * 8;
  const int rg = (lane & 15) >> 1, rq = lane >> 4;
  const int rs0 = (((rg >> 2) * 4) + (rq ^ (rg & 3))) * 8;
  const int rs1 = ((((rg >> 2) ^ 1) * 4) + (rq ^ (rg & 3))) * 8;
  u32x4 r0a[4], r0b[4];
  bf16x8 fa0[4], fb0[4], fa1[4], fb1[4];
  G_LOAD(r0a, r0b, 0)
  __syncthreads();
  G_WRITE(r0a, r0b, 0)
  __syncthreads();
  if (1 < nk) { G_LOAD(r0a, r0b, 64) }
  G_READ(fa0, fb0, 0, rs0)
#pragma unroll 1
  for (int kt = 0; kt < nk; ++kt) {
    const int buf = kt & 1;
    G_READ(fa1, fb1, buf, rs1)
    __builtin_amdgcn_sched_barrier(0);
    G_MMA(fa0, fb0)
    __builtin_amdgcn_sched_barrier(0);
    if (kt + 1 < nk) { G_WRITE(r0a, r0b, buf ^ 1) }
    if (kt + 2 < nk) { G_LOAD(r0a, r0b, (kt + 2) * 64) }
    __syncthreads();
    if (kt + 1 < nk) { G_READ(fa0, fb0, buf ^ 1, rs0) }
    __builtin_amdgcn_sched_barrier(0);
    G_MMA(fa1, fb1)
    __builtin_amdgcn_sched_barrier(0);
  }
}
DI void zero_acc(f32x4 (&acc)[4][4]) {
#pragma unroll
  for (int a = 0; a < 4; ++a)
#pragma unroll
    for (int b = 0; b < 4; ++b) acc[a][b] = f32x4{0.f, 0.f, 0.f, 0.f};
}

DI int win_orig_col(int n) { return n < 7168 ? n : (n < 13824 ? n + 16 : (n < 13840 ? n - 13824 + 7168 : -1)); }

template <bool WINMAP>
DI void transpose_tile(const float* __restrict__ src, size_t src_ld, u16* __restrict__ dst, size_t dst_ld, int r0, int c0, float* sT) {
  const int tid = TIDX();
  __syncthreads();
#pragma unroll 4
  for (int i = 0; i < 16; ++i) {
    const int r = i * 4 + (tid >> 6), c = tid & 63;
    int sc = c0 + c;
    if (WINMAP) sc = win_orig_col(sc);
    sT[r * 65 + c] = (sc >= 0) ? src[(size_t)(r0 + r) * src_ld + sc] : 0.f;
  }
  __syncthreads();
#pragma unroll 4
  for (int i = 0; i < 16; ++i) {
    const int c = i * 4 + (tid >> 6), r = tid & 63;
    dst[(size_t)(c0 + c) * dst_ld + r0 + r] = f2bf(sT[r * 65 + c]);
  }
}

DI void phase_prep0(const Params& p, const Bucket& bk, unsigned char* smem) {
  float* sT = (float*)smem;
  u16* WinT = (u16*)(p.ws + OFF_WIN);
  u16* WbT = (u16*)(p.ws + OFF_WB);
  u16* WoT = (u16*)(p.ws + OFF_WO);
  u16* WkvT = (u16*)(p.ws + OFF_WKV);
  u16* HM = (u16*)(p.ws + OFF_HM);
  u16* DFT = (u16*)(p.ws + OFF_DFT);
  constexpr int U_WIN = 4 * 220 * 16, U_WB = 4 * 4 * 8 * 16, U_WO = 4 * 16 * 16, U_WKV = 4 * 16 * 16, U_HM = 1536, U_DFT = 160, U_BT = 8;
  constexpr int TOT = U_WIN + U_WB + U_WO + U_WKV + U_HM + U_DFT + U_BT;
  const int tid = TIDX(), lane = tid & 63, w = tid >> 6;
  for (int u = VB(); u < TOT; u += VG()) {
    int v = u;
    if (v < U_WIN) {
      const int l = v / (220 * 16), r = v % (220 * 16), nt = r / 16, kt = r % 16;
      transpose_tile<true>(p.w_in + (size_t)l * DM * NORIG, NORIG, WinT + (size_t)l * LDZ * LDH, LDH, kt * 64, nt * 64, sT);
      continue;
    }
    v -= U_WIN;
    if (v < U_WB) {
      const int l = v / 512, r = v % 512, g = r / 128, r2 = r % 128, ct = r2 / 16, dt = r2 % 16;
      transpose_tile<false>(p.w_branch + ((size_t)(l * 4 + g) * 512) * DM, DM, WbT + (size_t)l * DM * LDG + g * 512, LDG, ct * 64, dt * 64, sT);
      continue;
    }
    v -= U_WB;
    if (v < U_WO) {
      const int l = v / 256, r = v % 256, kt = r / 16, nt = r % 16;
      transpose_tile<false>(p.w_out + (size_t)l * DM * DM, DM, WoT + (size_t)l * DM * LDH, LDH, kt * 64, nt * 64, sT);
      continue;
    }
    v -= U_WO;
    if (v < U_WKV) {
      const int l = v / 256, r = v % 256, kt = r / 16, nt = r % 16;
      transpose_tile<false>(p.w_mem_kv + (size_t)l * DM * DM, DM, WkvT + (size_t)l * DM * LDH, LDH, kt * 64, nt * 64, sT);
      continue;
    }
    v -= U_WKV;
    if (v < U_HM) {
      const int row = v;
      if (w == 0) {
        const float* src = (row < 1024) ? p.mem_prompt + (size_t)row * DM : p.mem_sample + (size_t)(row - 1024) * DM;
        float4 xv[4];
        float ss = 0.f;
#pragma unroll
        for (int i = 0; i < 4; ++i) { xv[i] = *(const float4*)(src + (i * 64 + lane) * 4); ss += xv[i].x * xv[i].x + xv[i].y * xv[i].y + xv[i].z * xv[i].z + xv[i].w * xv[i].w; }
        ss = wsum(ss);
        const float rstd = rsqrtf(ss * (1.f / DM) + EPSV);
        for (int l = 0; l < 4; ++l) {
#pragma unroll
          for (int i = 0; i < 4; ++i) {
            const float4 g = *(const float4*)(p.mem_norm + l * DM + (i * 64 + lane) * 4);
            u32x2 o; o.x = pack2(xv[i].x * rstd * g.x, xv[i].y * rstd * g.y); o.y = pack2(xv[i].z * rstd * g.z, xv[i].w * rstd * g.w);
            *(u32x2*)(HM + ((size_t)l * 1536 + row) * LDH + (i * 64 + lane) * 4) = o;
          }
        }
      }
      continue;
    }
    v -= U_HM;
    if (v >= U_DFT) {
      const int e = (v - U_DFT) * 256 + tid;
      if (e < 3 * 4 * 129) {
        const int gh = e / 129, i = e % 129, g = gh >> 2;
        ((float*)(p.ws + OFF_DFT + 98304))[e] = p.rel_bias[(int)bk.b[g][i] * 12 + gh];
      }
      continue;
    }
    {
      const int e = v * 256 + tid;
      if (e < 40960) {
        int N, idx, isS;
        if (e < 32768) { N = 128; isS = e >= 16384; idx = e & 16383; }
        else { N = 64; isS = (e - 32768) >= 4096; idx = (e - 32768) & 4095; }
        const int i = idx / N, j = idx % N;
        const float a = 2.f * (float)((i * j) % N) / (float)N;
        DFT[e] = f2bf(isS ? sinpif(a) : cospif(a));
      }
    }
  }
}

DI void phase_prep1(const Params& p, unsigned char* smem) {
  const u16* WkvT = (const u16*)(p.ws + OFF_WKV);
  const u16* HM = (const u16*)(p.ws + OFF_HM);
  u16* KVK = (u16*)(p.ws + OFF_KVK);
  u16* KVV = (u16*)(p.ws + OFF_KVV);
  const int tid = TIDX(), lane = tid & 63, w = tid >> 6, wm = w >> 1, wn = w & 1;
  for (int u = VB(); u < 4 * 12 * 8; u += VG()) {
    const int l = u / 96, r = u % 96, mt0 = r / 8, nt0 = r % 8;
    f32x4 acc[4][4];
    zero_acc(acc);
    gemm_acc<false, true>(acc, HM + ((size_t)l * 1536 + mt0 * 128) * LDH, LDH, WkvT + ((size_t)l * DM + nt0 * 128) * LDH, LDH, 16, (u16*)smem);
#pragma unroll
    for (int mt = 0; mt < 4; ++mt)
#pragma unroll
      for (int nt = 0; nt < 4; ++nt)
#pragma unroll
        for (int i = 0; i < 4; ++i) {
          const int row = mt0 * 128 + wm * 64 + mt * 16 + (lane & 15);
          const int col = nt0 * 128 + wn * 64 + nt * 16 + (lane >> 4) * 4 + i;
          const int b = row >> 8, m = row & 255;
          const int sel = col >> 9, h = (col >> 7) & 3, c = col & 127;
          const u16 val = f2bf(acc[mt][nt][i]);
          const size_t base = ((size_t)(l * 6 + b) * 4 + h) * 256 * 128;
          if (sel == 0) KVK[base + m * 128 + c] = val;
          else KVV[base + c * 256 + m] = val;
        }
  }
}

DI void phase_rows(const Params& p, const SB& sb, int l, int dry) {
  const u16* OUTB = (const u16*)(p.ws + OFF_OUT);
  u16* H = (u16*)(p.ws + OFF_H);
  const int tid = TIDX(), lane = tid & 63, w = tid >> 6;
#pragma unroll 2
  for (int row = VB() * 4 + w; row < MTOK; row += VG() * 4) {
    float4 xv[4];
    if (l == 0) {
#pragma unroll
      for (int i = 0; i < 4; ++i) xv[i] = *(const float4*)(sb.xin + (size_t)row * DM + (i * 64 + lane) * 4);
    } else {
      const float* xp = (l == 1 ? sb.xin : sb.xout) + (size_t)row * DM;
      float4 ov[4];
      float ss = 0.f;
#pragma unroll
      for (int i = 0; i < 4; ++i) { const u32x2 ob = *(const u32x2*)(OUTB + (size_t)row * DM + (i * 64 + lane) * 4);
        ov[i].x = bflo(ob.x); ov[i].y = bfhi(ob.x); ov[i].z = bflo(ob.y); ov[i].w = bfhi(ob.y);
        ss += ov[i].x * ov[i].x + ov[i].y * ov[i].y + ov[i].z * ov[i].z + ov[i].w * ov[i].w; }
      ss = wsum(ss);
      const float rstd = rsqrtf(ss * (1.f / DM) + EPSV);
#pragma unroll
      for (int i = 0; i < 4; ++i) {
        const float4 g = *(const float4*)(p.norm_post + (l - 1) * DM + (i * 64 + lane) * 4);
        const float4 xo = *(const float4*)(xp + (i * 64 + lane) * 4);
        xv[i].x = xo.x + ov[i].x * rstd * g.x; xv[i].y = xo.y + ov[i].y * rstd * g.y;
        xv[i].z = xo.z + ov[i].z * rstd * g.z; xv[i].w = xo.w + ov[i].w * rstd * g.w;
        if (!dry) *(float4*)(sb.xout + (size_t)row * DM + (i * 64 + lane) * 4) = xv[i];
      }
    }
    if (l < 4) {
      float ss = 0.f;
#pragma unroll
      for (int i = 0; i < 4; ++i) ss += xv[i].x * xv[i].x + xv[i].y * xv[i].y + xv[i].z * xv[i].z + xv[i].w * xv[i].w;
      ss = wsum(ss);
      const float rstd = rsqrtf(ss * (1.f / DM) + EPSV);
#pragma unroll
      for (int i = 0; i < 4; ++i) {
        const float4 g = *(const float4*)(p.norm_pre + l * DM + (i * 64 + lane) * 4);
        u32x2 o; o.x = pack2(xv[i].x * rstd * g.x, xv[i].y * rstd * g.y); o.y = pack2(xv[i].z * rstd * g.z, xv[i].w * rstd * g.w);
        *(u32x2*)(H + (size_t)row * LDH + (i * 64 + lane) * 4) = o;
      }
    }
  }
}

namespace pg8 {
#define PG8_LAS __attribute__((address_space(3)))
constexpr int BM = 256, BK = 64, HALF = 128, HTB = HALF * BK * 2, STAGE_BYTES = 8 * HTB, NXCD = 8, WGM = 8;
DI int lds_byte(int r, int c) { const int st = (r >> 4) * 2 + (c >> 5), rr = r & 15, cc = c & 31, ob = rr * 64 + cc * 2; return st * 1024 + (ob ^ (((ob >> 9) & 1) << 5)); }
DI void stage_rc(int b, int& R, int& C) { const int st = b / 1024, sb = b % 1024, swz = sb ^ (((sb >> 9) & 1) << 5); R = (st >> 1) * 16 + swz / 64; C = (st & 1) * 32 + (swz % 64) / 2; }
DI int perm32(int rho) { const int n = rho >> 4, i = rho & 15; return 8 * (i >> 2) + 4 * n + (i & 3); }
struct Unit { int pm, pn; };
struct Gemm { const u16* A; const u16* Bt; int M, N, K, ld; };
struct StaticOrder {
  int nM, nN, nwg, G, c;
  DI void init(int M, int N, int G_, int c_) { nM = M / BM; nN = N / BM; nwg = nM * nN; G = G_; c = c_; }
  DI bool next(int i, Unit& u) const {
    const long L = (long)i * G + c; if (L >= nwg) return false;
    int wgid = (int)L; { const int q = nwg / NXCD, r = nwg % NXCD, xcd = wgid % NXCD, off = wgid / NXCD; wgid = (xcd < r ? xcd * (q + 1) : r * (q + 1) + (xcd - r) * q) + off; }
    const int nig = WGM * nN, gid = wgid / nig, fm = gid * WGM, gsz = (nM - fm) < WGM ? (nM - fm) : WGM;
    u.pm = fm + ((wgid % nig) % gsz); u.pn = (wgid % nig) / gsz; return true;
  }
};
DI unsigned cvt_pk_bf16(float lo, float hi) { unsigned r; asm volatile("v_cvt_pk_bf16_f32 %0, %1, %2" : "=v"(r) : "v"(lo), "v"(hi)); return r; }
struct EpiF32 {
  static constexpr bool PERM = false;
  float* C; int ldc;
  DI void operator()(const f32x4 (&acc)[2][2][4][2], const Unit& u, int wr, int wc, int fr, int fq) const {
    const int row0 = u.pm * BM + wr * 64 + fr, col0 = u.pn * BM + wc * 32 + 4 * fq;
#pragma unroll
    for (int ai = 0; ai < 2; ++ai)
#pragma unroll
      for (int m = 0; m < 4; ++m) { float* rowp = C + (size_t)(row0 + ai * HALF + m * 16) * ldc + col0;
#pragma unroll
        for (int bj = 0; bj < 2; ++bj)
#pragma unroll
          for (int n = 0; n < 2; ++n) *(f32x4*)(rowp + bj * HALF + n * 16) = acc[ai][bj][m][n]; }
  }
};
struct EpiBf16 {
  static constexpr bool PERM = true;
  u16* O; int ldc;
  DI void operator()(const f32x4 (&acc)[2][2][4][2], const Unit& u, int wr, int wc, int fr, int fq) const {
    const int row0 = u.pm * BM + wr * 64 + fr, col0 = u.pn * BM + wc * 32 + 8 * fq;
#pragma unroll
    for (int ai = 0; ai < 2; ++ai)
#pragma unroll
      for (int m = 0; m < 4; ++m) { u16* rowp = O + (size_t)(row0 + ai * HALF + m * 16) * ldc + col0;
#pragma unroll
        for (int bj = 0; bj < 2; ++bj) { const f32x4 v0 = acc[ai][bj][m][0], v1 = acc[ai][bj][m][1];
          u32x4 w; w.x = cvt_pk_bf16(v0[0], v0[1]); w.y = cvt_pk_bf16(v0[2], v0[3]); w.z = cvt_pk_bf16(v1[0], v1[1]); w.w = cvt_pk_bf16(v1[2], v1[3]);
          *(u32x4*)(rowp + bj * HALF) = w; } }
  }
};
template <class Epi, class Sched>
DI void gemm_phase(PG8_LAS unsigned char* lds, const Gemm g, const Sched& S, const Epi& E) {
  int tid = threadIdx.x; asm volatile("" : "+v"(tid));
  const int wid = __builtin_amdgcn_readfirstlane(tid >> 6), lane = tid & 63, wr = wid >> 2, wc = wid & 3, fr = lane & 15, fq = lane >> 4;
  const int K = g.K, nt = K / BK, ld = g.ld;
  unsigned voffA[2], voffB[2];
#pragma unroll
  for (int i = 0; i < 2; ++i) { int R, C; stage_rc(tid * 16 + i * 8192, R, C); const int Rb = Epi::PERM ? ((R & ~31) + perm32(R & 31)) : R;
    voffA[i] = (unsigned)(R * ld + C) * 2u; voffB[i] = (unsigned)(Rb * ld + C) * 2u; }
  const size_t kstep = (size_t)(BK * 2);
  const size_t hstep = (size_t)HALF * ld * 2;
  const size_t tstep = 2 * hstep;
  const unsigned ldsw = (unsigned)wid * 1024u;
  const int aoff = lds_byte(wr * 64 + fr, fq * 8), boff = lds_byte(wc * 32 + fr, fq * 8);
#define PG8_SA(b, h) (((b) * 2 + (h)) * HTB)
#define PG8_SB(b, h) ((4 + (b) * 2 + (h)) * HTB)
#define PG8_STAGE(bufoff, gbase, voff) do { _Pragma("unroll") for (int _i = 0; _i < 2; ++_i) \
    __builtin_amdgcn_global_load_lds((const unsigned*)((const char*)(gbase) + (voff)[_i]), (PG8_LAS unsigned*)(lds + (bufoff) + ldsw + _i * 8192), 16, 0, 0); } while (0)
#define PG8_LDA(dst, b, h) do { _Pragma("unroll") for (int m = 0; m < 4; ++m) _Pragma("unroll") for (int k = 0; k < 2; ++k) dst[m][k] = *(const PG8_LAS bf16x8*)(lds + PG8_SA(b, h) + aoff + m * 2048 + k * 1024); } while (0)
#define PG8_LDB(dst, b, h) do { _Pragma("unroll") for (int n = 0; n < 2; ++n) _Pragma("unroll") for (int k = 0; k < 2; ++k) dst[n][k] = *(const PG8_LAS bf16x8*)(lds + PG8_SB(b, h) + boff + n * 2048 + k * 1024); } while (0)
#define PG8_MMA(ai, bj, At, Bt) do { __builtin_amdgcn_s_setprio(1); _Pragma("unroll") for (int m = 0; m < 4; ++m) _Pragma("unroll") for (int n = 0; n < 2; ++n) _Pragma("unroll") for (int k = 0; k < 2; ++k) \
    acc[ai][bj][m][n] = __builtin_amdgcn_mfma_f32_16x16x32_bf16(Bt[n][k], At[m][k], acc[ai][bj][m][n], 0, 0, 0); __builtin_amdgcn_s_setprio(0); } while (0)
#define PG8_WAIT_V(n) asm volatile("s_waitcnt vmcnt(" #n ")" ::: "memory")
#define PG8_WAIT_L(n) asm volatile("s_waitcnt lgkmcnt(" #n ")" ::: "memory")
#define PG8_BAR __builtin_amdgcn_s_barrier()
#define PG8_SCHED __builtin_amdgcn_sched_barrier(0)
  Unit cur, nxt; int ui = 0;
  if (!S.next(0, cur)) return;
  f32x4 acc[2][2][4][2];
#pragma unroll
  for (int a = 0; a < 2; ++a)
#pragma unroll
    for (int b = 0; b < 2; ++b)
#pragma unroll
      for (int m = 0; m < 4; ++m)
#pragma unroll
        for (int n = 0; n < 2; ++n) acc[a][b][m][n] = (f32x4){0.f, 0.f, 0.f, 0.f};
  bf16x8 At[4][2], B0[2][2], B1[2][2];
  const char* cA = (const char*)g.A + (size_t)cur.pm * tstep; const char* cB = (const char*)g.Bt + (size_t)cur.pn * tstep;
  PG8_STAGE(PG8_SB(0, 0), cB, voffB); PG8_STAGE(PG8_SA(0, 0), cA, voffA); PG8_STAGE(PG8_SB(0, 1), cB + hstep, voffB); PG8_STAGE(PG8_SA(0, 1), cA + hstep, voffA);
  if (wr == 1) PG8_BAR;
  PG8_WAIT_V(4); PG8_BAR;
  PG8_STAGE(PG8_SB(1, 0), cB + kstep, voffB); PG8_STAGE(PG8_SA(1, 0), cA + kstep, voffA); PG8_STAGE(PG8_SB(1, 1), cB + hstep + kstep, voffB);
  PG8_WAIT_V(6); PG8_BAR;
  for (;;) {
    const bool has_next = S.next(ui + 1, nxt);
    const char* nA = has_next ? (const char*)g.A + (size_t)nxt.pm * tstep : cA; const char* nB = has_next ? (const char*)g.Bt + (size_t)nxt.pn * tstep : cB;
    for (int t = 0; t < nt; t += 2) {
      const bool last = (t == nt - 2);
      const char* a1 = cA + (size_t)(t + 1) * kstep;
      const char* a2 = last ? nA : cA + (size_t)(t + 2) * kstep; const char* b2 = last ? nB : cB + (size_t)(t + 2) * kstep;
      const char* a3 = a2 + kstep; const char* b3 = b2 + kstep;
      PG8_LDB(B0, 0, 0); PG8_SCHED; PG8_LDA(At, 0, 0); PG8_STAGE(PG8_SA(1, 1), a1 + hstep, voffA);
      PG8_WAIT_L(8); PG8_BAR; PG8_WAIT_L(0); PG8_MMA(0, 0, At, B0); PG8_BAR; PG8_SCHED;
      PG8_LDB(B1, 0, 1); PG8_STAGE(PG8_SB(0, 0), b2, voffB);
      PG8_BAR; PG8_WAIT_L(0); PG8_MMA(0, 1, At, B1); PG8_BAR;
      PG8_LDA(At, 0, 1); PG8_STAGE(PG8_SA(0, 0), a2, voffA);
      PG8_BAR; PG8_WAIT_L(0); PG8_MMA(1, 0, At, B0); PG8_BAR; PG8_SCHED;
      PG8_STAGE(PG8_SB(0, 1), b2 + hstep, voffB);
      PG8_WAIT_V(6); PG8_BAR; PG8_MMA(1, 1, At, B1); PG8_BAR;
      PG8_LDB(B0, 1, 0); PG8_SCHED; PG8_LDA(At, 1, 0); PG8_STAGE(PG8_SA(0, 1), a2 + hstep, voffA);
      PG8_WAIT_L(8); PG8_BAR; PG8_WAIT_L(0); PG8_MMA(0, 0, At, B0); PG8_BAR; PG8_SCHED;
      PG8_LDB(B1, 1, 1); PG8_STAGE(PG8_SB(1, 0), b3, voffB);
      PG8_BAR; PG8_WAIT_L(0); PG8_MMA(0, 1, At, B1); PG8_BAR;
      PG8_LDA(At, 1, 1); PG8_STAGE(PG8_SA(1, 0), a3, voffA);
      PG8_BAR; PG8_WAIT_L(0); PG8_MMA(1, 0, At, B0); PG8_BAR; PG8_SCHED;
      PG8_STAGE(PG8_SB(1, 1), b3 + hstep, voffB);
      PG8_WAIT_V(6); PG8_BAR; PG8_MMA(1, 1, At, B1); PG8_BAR;
    }
    E(acc, cur, wr, wc, fr, fq);
    if (!has_next) break;
#pragma unroll
    for (int a = 0; a < 2; ++a)
#pragma unroll
      for (int b = 0; b < 2; ++b)
#pragma unroll
        for (int m = 0; m < 4; ++m)
#pragma unroll
          for (int n = 0; n < 2; ++n) acc[a][b][m][n] = (f32x4){0.f, 0.f, 0.f, 0.f};
    cur = nxt; cA = nA; cB = nB; ++ui;
  }
  PG8_WAIT_V(0);
  if (wr == 0) PG8_BAR;
  PG8_BAR;
#undef PG8_SA
#undef PG8_SB
#undef PG8_STAGE
#undef PG8_LDA
#undef PG8_LDB
#undef PG8_MMA
#undef PG8_WAIT_V
#undef PG8_WAIT_L
#undef PG8_BAR
#undef PG8_SCHED
}
}

DI void phase_inproj(const Params& p, int l, unsigned char* smem_base) {
  pg8::Gemm g; g.A = (const u16*)(p.ws + OFF_H); g.Bt = (const u16*)(p.ws + OFF_WIN) + (size_t)l * LDZ * LDH; g.M = MTOK; g.N = LDZ; g.K = DM; g.ld = LDH;
  pg8::StaticOrder S; S.init(MTOK, LDZ, gridDim.x, blockIdx.x);
  pg8::EpiBf16 E; E.O = (u16*)(p.ws + OFF_Z); E.ldc = LDZ;
  pg8::gemm_phase(( PG8_LAS unsigned char*)smem_base, g, S, E);
}

template <int NKT>
DI void attn_scores(f32x4 (&S)[NKT], const u16* sKw, const bf16x8 (&qf)[4], int lane) {
#pragma unroll
  for (int kt = 0; kt < NKT; ++kt) {
    S[kt] = f32x4{0.f, 0.f, 0.f, 0.f};
#pragma unroll
    for (int ks = 0; ks < 4; ++ks) {
      const bf16x8 kf = ldfrag(sKw + (kt * 16 + (lane & 15)) * 136 + ks * 32 + (lane >> 4) * 8);
      S[kt] = mfma16(kf, qf[ks], S[kt]);
    }
  }
}
template <int NKT>
DI void attn_pv(f32x4 (&O)[8], const f32x4 (&P)[NKT], const u16* sVTw, int ldv, int lane) {
#pragma unroll
  for (int ct = 0; ct < 8; ++ct) O[ct] = f32x4{0.f, 0.f, 0.f, 0.f};
#pragma unroll
  for (int pp = 0; pp < NKT / 2; ++pp) {
    bf16x8 pf;
#pragma unroll
    for (int j = 0; j < 4; ++j) { pf[j] = (short)f2bf(P[2 * pp][j]); pf[4 + j] = (short)f2bf(P[2 * pp + 1][j]); }
#pragma unroll
    for (int ct = 0; ct < 8; ++ct) {
      const u16* vp = sVTw + (ct * 16 + (lane & 15)) * ldv + (2 * pp) * 16 + (lane >> 4) * 4;
      const s16x4 lo = *(const s16x4*)vp;
      const s16x4 hi = *(const s16x4*)(vp + 16);
      const bf16x8 vf = __builtin_shufflevector(lo, hi, 0, 1, 2, 3, 4, 5, 6, 7);
      O[ct] = mfma16(vf, pf, O[ct]);
    }
  }
}

typedef short v4i16_t __attribute__((ext_vector_type(4)));
template <int NKT>
DI void attn_pv_tr(f32x4 (&O)[8], const f32x4 (&P)[NKT], const u16* sVw, int ldv, int lane) {
#pragma unroll
  for (int ct = 0; ct < 8; ++ct) O[ct] = f32x4{0.f, 0.f, 0.f, 0.f};
#pragma unroll
  for (int pp = 0; pp < NKT / 2; ++pp) {
    bf16x8 pf;
#pragma unroll
    for (int j = 0; j < 4; ++j) { pf[j] = (short)f2bf(P[2 * pp][j]); pf[4 + j] = (short)f2bf(P[2 * pp + 1][j]); }
    const u16* vrow = sVw + ((2 * pp) * 16 + (lane >> 4) * 4 + ((lane & 15) >> 2)) * ldv + (lane & 3) * 4;
#pragma unroll
    for (int ct = 0; ct < 8; ++ct) {
      const s16x4 lo = __builtin_bit_cast(s16x4, __builtin_amdgcn_ds_read_tr16_b64_v4i16((__attribute__((address_space(3))) v4i16_t*)(vrow + ct * 16)));
      const s16x4 hi = __builtin_bit_cast(s16x4, __builtin_amdgcn_ds_read_tr16_b64_v4i16((__attribute__((address_space(3))) v4i16_t*)(vrow + 16 * ldv + ct * 16)));
      const bf16x8 vf = __builtin_shufflevector(lo, hi, 0, 1, 2, 3, 4, 5, 6, 7);
      O[ct] = mfma16(vf, pf, O[ct]);
    }
  }
}

DI void unit_attnA(const Params& p, const Bucket& bk, const SB& sb, int u, unsigned char* smem, int dry) {
  u16* Z = (u16*)(p.ws + OFF_Z);
  float* LSE = (float*)(p.ws + OFF_LSE);
  u16* sK = (u16*)smem;
  float* sBias = (float*)(smem + 59904);
  const int tid = TIDX(), lane = tid & 63, w = tid >> 6;
  const int L = sb.L, B = sb.B, nblk = L / 64;
  const int blk = u % nblk; int t = u / nblk; const int b = t % B; const int gh = t / B; const int g = gh >> 2, h = gh & 3;
  const int d = (g == 0) ? 1 : (g == 1 ? 4 : 16);
  const int M = L / d, nbr = M / 64, r = blk / nbr, m0 = (blk % nbr) * 64;
  const size_t rowbase = (size_t)b * L;
  const int qcol = C_QA + g * 512 + h * 128, kcol = C_KA + g * 512 + h * 128, vcol = C_VA + g * 512 + h * 128;
  __syncthreads();
  if (tid < 129) sBias[tid] = ((const float*)(p.ws + OFF_DFT + 98304))[(g * 4 + h) * 129 + tid];
  for (int id = tid; id < 208 * 16; id += 256) {
    const int kk = id >> 4, ch = id & 15;
    const int km = m0 - 64 + kk;
    const int kmc = min(max(km, 0), M - 1);
    u32x4 v = *(const u32x4*)(Z + (rowbase + (size_t)kmc * d + r) * LDZ + kcol + ch * 8);
    if (km != kmc) v = u32x4{0u, 0u, 0u, 0u};
    *(u32x4*)(sK + kk * 136 + ch * 8) = v;
  }
  bf16x8 qf[4];
  const size_t qrow = rowbase + (size_t)(m0 + w * 16 + (lane & 15)) * d + r;
#pragma unroll
  for (int ks = 0; ks < 4; ++ks) qf[ks] = ldfrag(Z + qrow * LDZ + qcol + ks * 32 + (lane >> 4) * 8);
  u32x4 vreg[13];
#pragma unroll
  for (int i = 0; i < 13; ++i) {
    const int id = tid + i * 256, kk = id >> 4, ch = id & 15;
    const int km = m0 - 64 + kk;
    const int kmc = min(max(km, 0), M - 1);
    vreg[i] = *(const u32x4*)(Z + (rowbase + (size_t)kmc * d + r) * LDZ + vcol + ch * 8);
    if (km != kmc) vreg[i] = u32x4{0u, 0u, 0u, 0u};
  }
  __syncthreads();
  f32x4 S[10];
  attn_scores<10>(S, sK + (w * 16) * 136, qf, lane);
  float mx = -3.0e38f;
#pragma unroll
  for (int kt = 0; kt < 10; ++kt)
#pragma unroll
    for (int i = 0; i < 4; ++i) {
      const int kkr = kt * 16 + (lane >> 4) * 4 + i;
      const int rel = kkr - 64 - (lane & 15);
      const int km = m0 - 64 + w * 16 + kkr;
      const bool ok = (rel >= -64) && (rel <= 64) && (km >= 0) && (km < M);
      const int bi = min(max(rel + 64, 0), 128);
      const float s = ok ? S[kt][i] * QSCALE + sBias[bi] : -1e30f;
      S[kt][i] = s;
      mx = fmaxf(mx, s);
    }
  mx = fmaxf(mx, __shfl_xor(mx, 16));
  mx = fmaxf(mx, __shfl_xor(mx, 32));
  float sum = 0.f;
#pragma unroll
  for (int kt = 0; kt < 10; ++kt)
#pragma unroll
    for (int i = 0; i < 4; ++i) { const float e = __expf(S[kt][i] - mx); S[kt][i] = e; sum += e; }
  sum += __shfl_xor(sum, 16);
  sum += __shfl_xor(sum, 32);
  __syncthreads();
  u16* sV = sK;
#pragma unroll
  for (int i = 0; i < 13; ++i) {
    const int id = tid + i * 256, kk = id >> 4, ch = id & 15;
    *(u32x4*)(sV + kk * 144 + ch * 8) = vreg[i];
  }
  __syncthreads();
  f32x4 O[8];
  attn_pv_tr<10>(O, S, sV + (w * 16) * 144, 144, lane);
  const float inv = 1.f / sum;
  if (!dry) {
#pragma unroll
    for (int ct = 0; ct < 8; ++ct) {
      u32x2 o; o.x = pack2(O[ct][0] * inv, O[ct][1] * inv); o.y = pack2(O[ct][2] * inv, O[ct][3] * inv);
      *(u32x2*)(Z + qrow * LDZ + qcol + ct * 16 + (lane >> 4) * 4) = o;
    }
  }
  if ((lane >> 4) == 0) LSE[qrow * 12 + g * 4 + h] = mx + __logf(sum);
}

DI void unit_attnD(const Params& p, const SB& sb, int l, int u, unsigned char* smem) {
  const u16* Z = (const u16*)(p.ws + OFF_Z);
  u16* GATED = (u16*)(p.ws + OFF_GATED);
  u16* sK = (u16*)smem;
  const int tid = TIDX(), lane = tid & 63, w = tid >> 6;
  const int h = u & 3, rb = u >> 2;
  const int row0 = rb * 64;
  const int b = row0 / sb.L;
  const size_t kvbase = ((size_t)(l * 6 + sb.memb + b) * 4 + h) * 256 * 128;
  const u16* KVK = (const u16*)(p.ws + OFF_KVK) + kvbase;
  const u16* KVV = (const u16*)(p.ws + OFF_KVV) + kvbase;
  __syncthreads();
  for (int id = tid; id < 256 * 16; id += 256) {
    const int m = id >> 4, ch = id & 15;
    *(u32x4*)(sK + m * 136 + ch * 8) = *(const u32x4*)(KVK + m * 128 + ch * 8);
  }
  bf16x8 qf[4];
  const size_t qrow = (size_t)row0 + w * 16 + (lane & 15);
#pragma unroll
  for (int ks = 0; ks < 4; ++ks) qf[ks] = ldfrag(Z + qrow * LDZ + C_QD + h * 128 + ks * 32 + (lane >> 4) * 8);
  __syncthreads();
  f32x4 S[16];
  attn_scores<16>(S, sK, qf, lane);
  float mx = -3.0e38f;
#pragma unroll
  for (int kt = 0; kt < 16; ++kt)
#pragma unroll
    for (int i = 0; i < 4; ++i) { S[kt][i] *= QSCALE; mx = fmaxf(mx, S[kt][i]); }
  mx = fmaxf(mx, __shfl_xor(mx, 16));
  mx = fmaxf(mx, __shfl_xor(mx, 32));
  float sum = 0.f;
#pragma unroll
  for (int kt = 0; kt < 16; ++kt)
#pragma unroll
    for (int i = 0; i < 4; ++i) { const float e = __expf(S[kt][i] - mx); S[kt][i] = e; sum += e; }
  sum += __shfl_xor(sum, 16);
  sum += __shfl_xor(sum, 32);
  __syncthreads();
  u16* sVT = sK;
  for (int id = tid; id < 128 * 32; id += 256) {
    const int c = id >> 5, ch = id & 31;
    *(u32x4*)(sVT + c * 264 + ch * 8) = *(const u32x4*)(KVV + c * 256 + ch * 8);
  }
  __syncthreads();
  f32x4 O[8];
  attn_pv<16>(O, S, sVT, 264, lane);
  const float inv = 1.f / sum;
#pragma unroll
  for (int ct = 0; ct < 8; ++ct) {
    const int c = h * 128 + ct * 16 + (lane >> 4) * 4;
    u32x2 o;
    o.x = pack2(O[ct][0] * inv, O[ct][1] * inv);
    o.y = pack2(O[ct][2] * inv, O[ct][3] * inv);
    *(u32x2*)(GATED + qrow * LDG + 1536 + c) = o;
  }
}

DI void conv8(const u16* __restrict__ Zb, int L, int pos, int col, const float* __restrict__ cw, int cwcol, float (&o)[8]) {
  float a[8];
#pragma unroll
  for (int e = 0; e < 8; ++e) a[e] = 0.f;
  u32x4 zv[5];
#pragma unroll
  for (int j = 0; j < 5; ++j) {
    const int pp = min(max(pos + j - 2, 0), L - 1);
    zv[j] = *(const u32x4*)(Zb + (size_t)pp * LDZ + col);
  }
#pragma unroll
  for (int j = 0; j < 5; ++j) {
    const int pp = pos + j - 2;
    const float ok = (pp >= 0 && pp < L) ? 1.f : 0.f;
    float f[8];
    unpack8(zv[j], f);
    const float4 w0 = *(const float4*)(cw + j * 1024 + cwcol);
    const float4 w1 = *(const float4*)(cw + j * 1024 + cwcol + 4);
    a[0] += f[0] * (w0.x * ok); a[1] += f[1] * (w0.y * ok); a[2] += f[2] * (w0.z * ok); a[3] += f[3] * (w0.w * ok);
    a[4] += f[4] * (w1.x * ok); a[5] += f[5] * (w1.y * ok); a[6] += f[6] * (w1.z * ok); a[7] += f[7] * (w1.w * ok);
  }
#pragma unroll
  for (int e = 0; e < 8; ++e) o[e] = siluf_(a[e]);
}
DI void gate_stats(const Params& p, const u16* Zrow0  , int l, int h, int dir, int lane, int& t, float& bcum, float& uu, float& g) {
  t = dir ? 63 - lane : lane;
  const u16* zr = Zrow0 + (size_t)t * LDZ + C_GC + dir * 8 + h;
  const float ip = bf2f(zr[0]) + p.gate_bias[l * 16 + dir * 8 + h];
  const float fp = bf2f(zr[4]) + p.gate_bias[l * 16 + dir * 8 + 4 + h];
  float v = logsigf_(fp);
#pragma unroll
  for (int o = 1; o < 64; o <<= 1) { const float n = __shfl_up(v, o); if (lane >= o) v += n; }
  bcum = v;
  g = __shfl(v, 63);
  uu = ip - v;
}

DI void unit_mlstm_local(const Params& p, const SB& sb, int l, int u, unsigned char* smem) {
  const u16* Z = (const u16*)(p.ws + OFF_Z);
  u16* CS = (u16*)(p.ws + OFF_CS);
  float* NS = (float*)(p.ws + OFF_NS);
  float* SCG = (float*)(p.ws + OFF_SC);
  float* SCMA = SCG + 2048;
  u16* sKW = (u16*)smem;
  u16* sVT = sKW + 2 * 128 * 72;
  float* sWa = (float*)(sVT + 128 * 72);
  const int tid = TIDX(), lane = tid & 63, w = tid >> 6;
  const int N = sb.L / 64;
  const int h = u & 3; int cidx = u >> 2; const int n = cidx % N, b = cidx / N;
  const size_t row0 = (size_t)b * sb.L + (size_t)n * 64;
  __syncthreads();
  if (w < 2) {
    int t; float bc, uu, g;
    gate_stats(p, Z + row0 * LDZ, l, h, w, lane, t, bc, uu, g);
    const float a = g + uu;
    const float ma = wmaxr(a);
    sWa[w * 64 + t] = __expf(a - ma);
    if (lane == 0) { const int seq = (b * 4 + h) * 2 + w; SCG[seq * N + n] = g; SCMA[seq * N + n] = ma; }
  }
  __syncthreads();
  const u16* Zb = Z + (size_t)b * sb.L * LDZ;
  const float* cw = p.conv_qk + (size_t)l * 5 * 1024;
#pragma unroll 1
  for (int i = 0; i < 4; ++i) {
    const int id = tid + i * 256, t = id & 63, ch = id >> 6;
    float km[8];
    conv8(Zb, sb.L, n * 64 + t, C_KC + h * 128 + ch * 8, cw, 512 + h * 128 + ch * 8, km);
    const float wf = sWa[t], wb = sWa[64 + t];
    const u32x4 vv = *(const u32x4*)(Z + (row0 + t) * LDZ + C_VC + h * 128 + ch * 8);
    const unsigned vw[4] = {vv.x, vv.y, vv.z, vv.w};
#pragma unroll
    for (int e = 0; e < 8; ++e) {
      sKW[(ch * 8 + e) * 72 + t] = f2bf(km[e] * wf);
      sKW[(128 + ch * 8 + e) * 72 + t] = f2bf(km[e] * wb);
      sVT[(ch * 8 + e) * 72 + t] = (u16)((e & 1) ? (vw[e >> 1] >> 16) : (vw[e >> 1] & 0xffff));
    }
  }
  __syncthreads();
  {
    const int dir = tid >> 7, dd = tid & 127;
    float s = 0.f;
    const u16* kp = sKW + (dir * 128 + dd) * 72;
#pragma unroll 8
    for (int t = 0; t < 64; ++t) s += bf2f(kp[t]);
    const int seq = (b * 4 + h) * 2 + dir;
    NS[((size_t)seq * N + n) * 128 + dd] = s;
  }
#pragma unroll 1
  for (int dir = 0; dir < 2; ++dir) {
    f32x4 acc[2][8];
#pragma unroll
    for (int a = 0; a < 2; ++a)
#pragma unroll
      for (int c = 0; c < 8; ++c) acc[a][c] = f32x4{0.f, 0.f, 0.f, 0.f};
#pragma unroll
    for (int ks = 0; ks < 2; ++ks) {
      bf16x8 af[2], bfv[8];
#pragma unroll
      for (int mt = 0; mt < 2; ++mt) af[mt] = ldfrag(sKW + (dir * 128 + w * 32 + mt * 16 + (lane & 15)) * 72 + ks * 32 + (lane >> 4) * 8);
#pragma unroll
      for (int nt = 0; nt < 8; ++nt) bfv[nt] = ldfrag(sVT + (nt * 16 + (lane & 15)) * 72 + ks * 32 + (lane >> 4) * 8);
#pragma unroll
      for (int mt = 0; mt < 2; ++mt)
#pragma unroll
        for (int nt = 0; nt < 8; ++nt) acc[mt][nt] = mfma16(af[mt], bfv[nt], acc[mt][nt]);
    }
    const int seq = (b * 4 + h) * 2 + dir;
    u16* cs = CS + ((size_t)seq * N + n) * 16384;
#pragma unroll
    for (int mt = 0; mt < 2; ++mt)
#pragma unroll
      for (int nt = 0; nt < 8; ++nt) {
        const int e = nt * 16 + (lane & 15), dd = w * 32 + mt * 16 + (lane >> 4) * 4;
        u32x2 o; o.x = pack2(acc[mt][nt][0], acc[mt][nt][1]); o.y = pack2(acc[mt][nt][2], acc[mt][nt][3]);
        *(u32x2*)(cs + e * 128 + dd) = o;
      }
  }
}

DI void unit_mlstm_scan(const Params& p, const SB& sb, int u, unsigned char* smem, int dry) {
  u16* CS = (u16*)(p.ws + OFF_CS);
  float* NS = (float*)(p.ws + OFF_NS);
  const float* SCG = (const float*)(p.ws + OFF_SC);
  const float* SCMA = SCG + 2048;
  float* SCMP = (float*)(p.ws + OFF_SC) + 4096;
  float* sOld = (float*)smem;
  float* sNew = sOld + 256;
  const int tid = TIDX();
  const int N = sb.L / 64;
  const int seq = u >> 5, slab = u & 31, dir = seq & 1;
  __syncthreads();
  if (tid < N) { sOld[tid] = SCG[seq * N + tid]; sNew[tid] = SCMA[seq * N + tid]; }
  __syncthreads();
  if (tid == 0) {
    float m = 0.f;
    for (int i = 0; i < N; ++i) {
      const int n = dir ? N - 1 - i : i;
      const float g = sOld[n], ma = sNew[n];
      const float mn = fmaxf(g + m, ma);
      sOld[n] = __expf(g + m - mn);
      sNew[n] = __expf(ma - mn);
      if (slab == 0) SCMP[seq * N + n] = m;
      m = mn;
    }
  }
  __syncthreads();
  unsigned* cs = (unsigned*)(CS + (size_t)seq * N * 16384) + slab * 256 + tid;
  float c0 = 0.f, c1 = 0.f;
  for (int i0 = 0; i0 < N; i0 += 32) {
    unsigned v[32];
#pragma unroll
    for (int j = 0; j < 32; ++j) { const int n = dir ? N - 1 - (i0 + j) : i0 + j; v[j] = cs[(size_t)n * 8192]; }
#pragma unroll
    for (int j = 0; j < 32; ++j) {
      const int n = dir ? N - 1 - (i0 + j) : i0 + j;
      if (!dry) cs[(size_t)n * 8192] = pack2(c0, c1);
      const float so = sOld[n], sn = sNew[n];
      c0 = so * c0 + sn * bflo(v[j]);
      c1 = so * c1 + sn * bfhi(v[j]);
    }
  }
  if (slab == 0 && tid < 128) {
    float* ns = NS + (size_t)seq * N * 128 + tid;
    float a = 0.f;
    for (int i0 = 0; i0 < N; i0 += 16) {
      float v[16];
#pragma unroll
      for (int j = 0; j < 16; ++j) { const int n = dir ? N - 1 - (i0 + j) : i0 + j; v[j] = ns[(size_t)n * 128]; }
#pragma unroll
      for (int j = 0; j < 16; ++j) {
        const int n = dir ? N - 1 - (i0 + j) : i0 + j;
        if (!dry) ns[(size_t)n * 128] = a;
        a = sOld[n] * a + sNew[n] * v[j];
      }
    }
  }
}

DI void unit_mlstm_out(const Params& p, const SB& sb, int l, int u, unsigned char* smem) {
  const u16* Z = (const u16*)(p.ws + OFF_Z);
  const u16* CS = (const u16*)(p.ws + OFF_CS);
  const float* NS = (const float*)(p.ws + OFF_NS);
  const float* SCMP = (const float*)(p.ws + OFF_SC) + 4096;
  u16* GATED = (u16*)(p.ws + OFF_GATED);
  u16* sQ = (u16*)smem;
  u16* sK = sQ + 64 * 136;
  u16* sV = sK + 64 * 136;
  u16* sSQ = sV + 64 * 144;
  float* sU = (float*)(sSQ + 64 * 72);
  float* sMx = sU + 128;
  float* sB = sMx + 128;
  float* sNp = sB + 128;
  float* sMp = sNp + 256;
  const int tid = TIDX(), lane = tid & 63, w = tid >> 6;
  const int N = sb.L / 64;
  const int h = u & 3; int cidx = u >> 2; const int n = cidx % N, b = cidx / N;
  const size_t row0 = (size_t)b * sb.L + (size_t)n * 64;
  const int seq0 = (b * 4 + h) * 2;
  __syncthreads();
  if (w < 2) {
    int t; float bc, uu, g;
    gate_stats(p, Z + row0 * LDZ, l, h, w, lane, t, bc, uu, g);
    float pm = uu;
#pragma unroll
    for (int o = 1; o < 64; o <<= 1) { const float nn = __shfl_up(pm, o); if (lane >= o) pm = fmaxf(pm, nn); }
    const float mp = SCMP[(seq0 + w) * N + n];
    sU[w * 64 + t] = uu;
    sMx[w * 64 + t] = fmaxf(mp, pm);
    sB[w * 64 + t] = bc;
    if (lane == 0) sMp[w] = mp;
  }
  {
    const int dir = tid >> 7, dd = tid & 127;
    sNp[tid] = NS[((size_t)(seq0 + dir) * N + n) * 128 + dd];
  }
  const u16* Zb = Z + (size_t)b * sb.L * LDZ;
  const float* cw = p.conv_qk + (size_t)l * 5 * 1024;
#pragma unroll 1
  for (int i = 0; i < 4; ++i) {
    const int id = tid + i * 256, ch = id & 15, t = id >> 4;
    float qm[8], km[8];
    const u32x4 vv = *(const u32x4*)(Z + (row0 + t) * LDZ + C_VC + h * 128 + ch * 8);
    conv8(Zb, sb.L, n * 64 + t, C_QC + h * 128 + ch * 8, cw, h * 128 + ch * 8, qm);
    conv8(Zb, sb.L, n * 64 + t, C_KC + h * 128 + ch * 8, cw, 512 + h * 128 + ch * 8, km);
    u32x4 qo, ko;
    qo.x = pack2(qm[0] * QSCALE, qm[1] * QSCALE); qo.y = pack2(qm[2] * QSCALE, qm[3] * QSCALE);
    qo.z = pack2(qm[4] * QSCALE, qm[5] * QSCALE); qo.w = pack2(qm[6] * QSCALE, qm[7] * QSCALE);
    ko.x = pack2(km[0], km[1]); ko.y = pack2(km[2], km[3]); ko.z = pack2(km[4], km[5]); ko.w = pack2(km[6], km[7]);
    *(u32x4*)(sQ + t * 136 + ch * 8) = qo;
    *(u32x4*)(sK + t * 136 + ch * 8) = ko;
    *(u32x4*)(sV + t * 144 + ch * 8) = vv;
  }
  __syncthreads();
  const int tq = w * 16 + (lane & 15);
  f32x4 S[4];
  {
    bf16x8 qf[4];
#pragma unroll
    for (int ks = 0; ks < 4; ++ks) qf[ks] = ldfrag(sQ + tq * 136 + ks * 32 + (lane >> 4) * 8);
#pragma unroll
    for (int mt = 0; mt < 4; ++mt) {
      S[mt] = f32x4{0.f, 0.f, 0.f, 0.f};
#pragma unroll
      for (int ks = 0; ks < 4; ++ks) {
        const bf16x8 kf = ldfrag(sK + (mt * 16 + (lane & 15)) * 136 + ks * 32 + (lane >> 4) * 8);
        S[mt] = mfma16(kf, qf[ks], S[mt]);
      }
    }
  }
  f32x4 hc[8];
#pragma unroll
  for (int mt = 0; mt < 8; ++mt) hc[mt] = f32x4{0.f, 0.f, 0.f, 0.f};
#pragma unroll 1
  for (int dir = 0; dir < 2; ++dir) {
    const float Mx = sMx[dir * 64 + tq];
    const float mp = sMp[dir];
    const float winter = __expf(mp - Mx);
    const float em = __expf(-(sB[dir * 64 + tq] + Mx));
    float dq = 0.f;
    {
      const u16* qp = sQ + tq * 136 + (lane >> 4) * 32;
      const float* np_ = sNp + dir * 128 + (lane >> 4) * 32;
#pragma unroll 8
      for (int j = 0; j < 32; ++j) dq += bf2f(qp[j]) * np_[j];
    }
    dq += __shfl_xor(dq, 16);
    dq += __shfl_xor(dq, 32);
    float dsum = 0.f;
    __syncthreads();
#pragma unroll
    for (int mt = 0; mt < 4; ++mt) {
      float v[4];
#pragma unroll
      for (int i = 0; i < 4; ++i) {
        const int s = mt * 16 + (lane >> 4) * 4 + i;
        const bool ok = dir ? (s >= tq) : (s <= tq);
        const float wi = ok ? __expf(fminf(sU[dir * 64 + s] - Mx, 0.f)) : 0.f;
        v[i] = S[mt][i] * wi;
        dsum += v[i];
      }
      u32x2 o; o.x = pack2(v[0], v[1]); o.y = pack2(v[2], v[3]);
      *(u32x2*)(sSQ + tq * 72 + mt * 16 + (lane >> 4) * 4) = o;
    }
    dsum += __shfl_xor(dsum, 16);
    dsum += __shfl_xor(dsum, 32);
    const float den = winter * dq + dsum;
    const float rden = 1.f / fmaxf(fabsf(den), em);
    __syncthreads();
    const u16* cs = CS + ((size_t)(seq0 + dir) * N + n) * 16384;
    f32x4 acc[8];
#pragma unroll
    for (int mt = 0; mt < 8; ++mt) acc[mt] = f32x4{0.f, 0.f, 0.f, 0.f};
#pragma unroll
    for (int ks = 0; ks < 4; ++ks) {
      const bf16x8 qf = ldfrag(sQ + tq * 136 + ks * 32 + (lane >> 4) * 8);
#pragma unroll
      for (int mt = 0; mt < 8; ++mt) {
        const bf16x8 cf = ldfrag(cs + (mt * 16 + (lane & 15)) * 128 + ks * 32 + (lane >> 4) * 8);
        acc[mt] = mfma16(cf, qf, acc[mt]);
      }
    }
#pragma unroll
    for (int mt = 0; mt < 8; ++mt)
#pragma unroll
      for (int i = 0; i < 4; ++i) acc[mt][i] *= winter;
#pragma unroll
    for (int ks = 0; ks < 2; ++ks) {
      const bf16x8 pf = ldfrag(sSQ + tq * 72 + ks * 32 + (lane >> 4) * 8);
#pragma unroll
      for (int mt = 0; mt < 8; ++mt) {
        const u16* vp = sV + (ks * 32 + (lane >> 4) * 8 + ((lane & 15) >> 2)) * 144 + mt * 16 + (lane & 3) * 4;
        const s16x4 vlo = __builtin_bit_cast(s16x4, __builtin_amdgcn_ds_read_tr16_b64_v4i16((__attribute__((address_space(3))) v4i16_t*)vp));
        const s16x4 vhi = __builtin_bit_cast(s16x4, __builtin_amdgcn_ds_read_tr16_b64_v4i16((__attribute__((address_space(3))) v4i16_t*)(vp + 4 * 144)));
        const bf16x8 vf = __builtin_shufflevector(vlo, vhi, 0, 1, 2, 3, 4, 5, 6, 7);
        acc[mt] = mfma16(vf, pf, acc[mt]);
      }
    }
#pragma unroll
    for (int mt = 0; mt < 8; ++mt)
#pragma unroll
      for (int i = 0; i < 4; ++i) hc[mt][i] += acc[mt][i] * rden;
  }
  const size_t row = row0 + tq;
  float s1 = 0.f;
#pragma unroll
  for (int mt = 0; mt < 8; ++mt) {
    const u32x2 oc = *(const u32x2*)(Z + row * LDZ + C_OC + h * 128 + mt * 16 + (lane >> 4) * 4);
    hc[mt][0] *= sigmoidf_(bflo(oc.x)); hc[mt][1] *= sigmoidf_(bfhi(oc.x));
    hc[mt][2] *= sigmoidf_(bflo(oc.y)); hc[mt][3] *= sigmoidf_(bfhi(oc.y));
    s1 += hc[mt][0] + hc[mt][1] + hc[mt][2] + hc[mt][3];
  }
  s1 += __shfl_xor(s1, 16);
  s1 += __shfl_xor(s1, 32);
  const float mu = s1 * (1.f / 128.f);
  float s2 = 0.f;
#pragma unroll
  for (int mt = 0; mt < 8; ++mt)
#pragma unroll
    for (int i = 0; i < 4; ++i) { const float dlt = hc[mt][i] - mu; s2 += dlt * dlt; }
  s2 += __shfl_xor(s2, 16);
  s2 += __shfl_xor(s2, 32);
  const float rs = rsqrtf(s2 * (1.f / 128.f) + EPSV);
#pragma unroll
  for (int mt = 0; mt < 8; ++mt) {
    const int c = h * 128 + mt * 16 + (lane >> 4) * 4;
    const float4 hg = *(const float4*)(p.head_gain + l * 512 + c);
    const u32x2 gp = *(const u32x2*)(Z + row * LDZ + C_GP + 2 * 512 + c);
    u32x2 o;
    o.x = pack2((hc[mt][0] - mu) * rs * hg.x * siluf_(bflo(gp.x)), (hc[mt][1] - mu) * rs * hg.y * siluf_(bfhi(gp.x)));
    o.y = pack2((hc[mt][2] - mu) * rs * hg.z * siluf_(bflo(gp.y)), (hc[mt][3] - mu) * rs * hg.w * siluf_(bfhi(gp.y)));
    *(u32x2*)(GATED + row * LDG + 1024 + c) = o;
  }
}

template <int N1>
DI void unit_fft1(const Params& p, const SB& sb, int u, unsigned char* smem) {
  constexpr int N2 = N1;
  constexpr int LDU = N1 + 8;
  constexpr int MTW = N1 / 64;
  const u16* Z = (const u16*)(p.ws + OFF_Z);
  const u16* DFT = (const u16*)(p.ws + OFF_DFT);
  const u16* DC128 = DFT, *DS128 = DFT + 16384;
  const u16* DC1 = (N1 == 128) ? DFT : DFT + 32768;
  const u16* DS1 = (N1 == 128) ? DFT + 16384 : DFT + 36864;
  u16* HR = (u16*)(p.ws + OFF_OUT);
  u16* HI = HR + (size_t)MTOK * 512;
  u16* sX = (u16*)smem;
  u16* sUT = sX + 128 * 136;
  u16* sVT = sUT + 64 * 136;
  const int tid = TIDX(), lane = tid & 63, w = tid >> 6;
  const int qh = u & 1, g4 = (u >> 1) & 3; int t2 = u >> 3; const int n2 = t2 % N2, b = t2 / N2;
  const int L = sb.L;
  __syncthreads();
  for (int id = tid; id < N1 * 16; id += 256) {
    const int n1 = id >> 4, ch = id & 15;
    *(u32x4*)(sX + n1 * 136 + ch * 8) = *(const u32x4*)(Z + ((size_t)b * L + (size_t)N2 * n1 + n2) * LDZ + C_XB + g4 * 128 + ch * 8);
  }
  __syncthreads();
  {
    f32x4 au[MTW][4], av[MTW][4];
#pragma unroll
    for (int a = 0; a < MTW; ++a)
#pragma unroll
      for (int c = 0; c < 4; ++c) { au[a][c] = f32x4{0.f, 0.f, 0.f, 0.f}; av[a][c] = f32x4{0.f, 0.f, 0.f, 0.f}; }
#pragma unroll
    for (int ks = 0; ks < 4; ++ks) {
      bf16x8 xf[MTW], cf[4], sf[4];
#pragma unroll
      for (int mt = 0; mt < MTW; ++mt) xf[mt] = ldfrag(sX + ((w * MTW + mt) * 16 + (lane & 15)) * 136 + ks * 32 + (lane >> 4) * 8);
#pragma unroll
      for (int nt = 0; nt < 4; ++nt) {
        const int q = qh * 64 + nt * 16 + (lane & 15);
        cf[nt] = ldfrag(DC128 + q * 128 + ks * 32 + (lane >> 4) * 8);
        sf[nt] = ldfrag(DS128 + q * 128 + ks * 32 + (lane >> 4) * 8);
      }
#pragma unroll
      for (int mt = 0; mt < MTW; ++mt)
#pragma unroll
        for (int nt = 0; nt < 4; ++nt) { au[mt][nt] = mfma16(xf[mt], cf[nt], au[mt][nt]); av[mt][nt] = mfma16(xf[mt], sf[nt], av[mt][nt]); }
    }
#pragma unroll
    for (int mt = 0; mt < MTW; ++mt)
#pragma unroll
      for (int nt = 0; nt < 4; ++nt) {
        const int ql = nt * 16 + (lane & 15), n1 = (w * MTW + mt) * 16 + (lane >> 4) * 4;
        u32x2 o; o.x = pack2(au[mt][nt][0], au[mt][nt][1]); o.y = pack2(au[mt][nt][2], au[mt][nt][3]);
        *(u32x2*)(sUT + ql * LDU + n1) = o;
        o.x = pack2(av[mt][nt][0], av[mt][nt][1]); o.y = pack2(av[mt][nt][2], av[mt][nt][3]);
        *(u32x2*)(sVT + ql * LDU + n1) = o;
      }
  }
  __syncthreads();
  f32x4 gr[MTW][4], gi[MTW][4];
#pragma unroll
  for (int a = 0; a < MTW; ++a)
#pragma unroll
    for (int c = 0; c < 4; ++c) { gr[a][c] = f32x4{0.f, 0.f, 0.f, 0.f}; gi[a][c] = f32x4{0.f, 0.f, 0.f, 0.f}; }
#pragma unroll
  for (int ks = 0; ks < N1 / 32; ++ks) {
    bf16x8 uf[4], vf[4];
#pragma unroll
    for (int nt = 0; nt < 4; ++nt) {
      uf[nt] = ldfrag(sUT + (nt * 16 + (lane & 15)) * LDU + ks * 32 + (lane >> 4) * 8);
      vf[nt] = ldfrag(sVT + (nt * 16 + (lane & 15)) * LDU + ks * 32 + (lane >> 4) * 8);
    }
#pragma unroll
    for (int mt = 0; mt < MTW; ++mt) {
      const int k1 = (w * MTW + mt) * 16 + (lane & 15);
      const bf16x8 cf = ldfrag(DC1 + k1 * N1 + ks * 32 + (lane >> 4) * 8);
      const bf16x8 sf = ldfrag(DS1 + k1 * N1 + ks * 32 + (lane >> 4) * 8);
      const bf16x8 sn = negfrag(sf);
#pragma unroll
      for (int nt = 0; nt < 4; ++nt) {
        gr[mt][nt] = mfma16(uf[nt], cf, gr[mt][nt]);
        gr[mt][nt] = mfma16(vf[nt], sn, gr[mt][nt]);
        gi[mt][nt] = mfma16(uf[nt], sf, gi[mt][nt]);
        gi[mt][nt] = mfma16(vf[nt], cf, gi[mt][nt]);
      }
    }
  }
  const float sc = rsqrtf((float)(N1 * 128));
#pragma unroll
  for (int mt = 0; mt < MTW; ++mt) {
    const int k1 = (w * MTW + mt) * 16 + (lane & 15);
    const float ang = 2.f * (float)((n2 * k1) % L) / (float)L;
    const float cph = cospif(ang) * sc, sph = sinpif(ang) * sc;
    const size_t base = (((size_t)b * N1 + k1) * N2 + n2) * 512 + g4 * 128 + qh * 64;
#pragma unroll
    for (int nt = 0; nt < 4; ++nt) {
      float hr[4], hi[4];
#pragma unroll
      for (int i = 0; i < 4; ++i) { hr[i] = gr[mt][nt][i] * cph - gi[mt][nt][i] * sph; hi[i] = gr[mt][nt][i] * sph + gi[mt][nt][i] * cph; }
      u32x2 o; o.x = pack2(hr[0], hr[1]); o.y = pack2(hr[2], hr[3]);
      *(u32x2*)(HR + base + nt * 16 + (lane >> 4) * 4) = o;
      o.x = pack2(hi[0], hi[1]); o.y = pack2(hi[2], hi[3]);
      *(u32x2*)(HI + base + nt * 16 + (lane >> 4) * 4) = o;
    }
  }
}

template <int N2>
DI void unit_fft2(const Params& p, const SB& sb, int u, unsigned char* smem) {
  constexpr int N1 = N2;
  constexpr int LDH = N2 + 8;
  constexpr int MTW = N2 / 64;
  const u16* Z = (const u16*)(p.ws + OFF_Z);
  const u16* DFT = (const u16*)(p.ws + OFF_DFT);
  const u16* DC2 = (N2 == 128) ? DFT : DFT + 32768;
  const u16* DS2 = (N2 == 128) ? DFT + 16384 : DFT + 36864;
  const u16* HR = (const u16*)(p.ws + OFF_OUT);
  const u16* HI = HR + (size_t)MTOK * 512;
  u16* GATED = (u16*)(p.ws + OFF_GATED);
  u16* sHr = (u16*)smem;
  u16* sHi = sHr + 128 * 136;
  const int tid = TIDX(), lane = tid & 63, w = tid >> 6;
  const int g4 = u & 3; int t2 = u >> 2; const int k1 = t2 % N1, b = t2 / N1;
  const int L = sb.L;
  __syncthreads();
  for (int id = tid; id < N2 * 16; id += 256) {
    const int n2 = id % N2, ch = id / N2;
    const size_t src = (((size_t)b * N1 + k1) * N2 + n2) * 512 + g4 * 128 + ch * 8;
    const u32x4 a = *(const u32x4*)(HR + src);
    const u32x4 c = *(const u32x4*)(HI + src);
    const unsigned aw[4] = {a.x, a.y, a.z, a.w}, cw[4] = {c.x, c.y, c.z, c.w};
#pragma unroll
    for (int e = 0; e < 8; ++e) {
      sHr[(ch * 8 + e) * LDH + n2] = (u16)((e & 1) ? (aw[e >> 1] >> 16) : (aw[e >> 1] & 0xffff));
      sHi[(ch * 8 + e) * LDH + n2] = (u16)((e & 1) ? (cw[e >> 1] >> 16) : (cw[e >> 1] & 0xffff));
    }
  }
  __syncthreads();
  f32x4 acc[MTW][8];
#pragma unroll
  for (int a = 0; a < MTW; ++a)
#pragma unroll
    for (int c = 0; c < 8; ++c) acc[a][c] = f32x4{0.f, 0.f, 0.f, 0.f};
#pragma unroll
  for (int ks = 0; ks < N2 / 32; ++ks) {
    bf16x8 cf[MTW], sn[MTW];
#pragma unroll
    for (int mt = 0; mt < MTW; ++mt) {
      const int k2 = (w * MTW + mt) * 16 + (lane & 15);
      cf[mt] = ldfrag(DC2 + k2 * N2 + ks * 32 + (lane >> 4) * 8);
      sn[mt] = negfrag(ldfrag(DS2 + k2 * N2 + ks * 32 + (lane >> 4) * 8));
    }
#pragma unroll
    for (int nt = 0; nt < 8; ++nt) {
      const bf16x8 hr = ldfrag(sHr + (nt * 16 + (lane & 15)) * LDH + ks * 32 + (lane >> 4) * 8);
      const bf16x8 hi = ldfrag(sHi + (nt * 16 + (lane & 15)) * LDH + ks * 32 + (lane >> 4) * 8);
#pragma unroll
      for (int mt = 0; mt < MTW; ++mt) { acc[mt][nt] = mfma16(hr, cf[mt], acc[mt][nt]); acc[mt][nt] = mfma16(hi, sn[mt], acc[mt][nt]); }
    }
  }
  const float sc = rsqrtf((float)N2);
#pragma unroll
  for (int mt = 0; mt < MTW; ++mt) {
    const int k2 = (w * MTW + mt) * 16 + (lane & 15);
    const size_t row = (size_t)b * L + (size_t)k1 + (size_t)N1 * k2;
#pragma unroll
    for (int nt = 0; nt < 8; ++nt) {
      const int c = g4 * 128 + nt * 16 + (lane >> 4) * 4;
      const u32x2 gp = *(const u32x2*)(Z + row * LDZ + C_GP + 512 + c);
      u32x2 o;
      o.x = pack2(acc[mt][nt][0] * sc * siluf_(bflo(gp.x)), acc[mt][nt][1] * sc * siluf_(bfhi(gp.x)));
      o.y = pack2(acc[mt][nt][2] * sc * siluf_(bflo(gp.y)), acc[mt][nt][3] * sc * siluf_(bfhi(gp.y)));
      *(u32x2*)(GATED + row * LDG + 512 + c) = o;
    }
  }
}

DI void unit_attn_combine(const Params& p, int u) {
  const u16* Z = (const u16*)(p.ws + OFF_Z);
  const float* LSE = (const float*)(p.ws + OFF_LSE);
  u16* GATED = (u16*)(p.ws + OFF_GATED);
  const int tid = TIDX(), lane = tid & 63, w = tid >> 6;
#pragma unroll 1
  for (int rr = 0; rr < 4; ++rr) {
    const size_t row = (size_t)u * 16 + w * 4 + rr;
    const int c = lane * 8, h = c >> 7;
    const float l0 = LSE[row * 12 + h], l1 = LSE[row * 12 + 4 + h], l2 = LSE[row * 12 + 8 + h];
    const float mx = fmaxf(l0, fmaxf(l1, l2));
    const float e0 = __expf(l0 - mx), e1 = __expf(l1 - mx), e2 = __expf(l2 - mx);
    const float inv = 1.f / (e0 + e1 + e2);
    float o0[8], o1[8], o2[8], gp[8];
    unpack8(*(const u32x4*)(Z + row * LDZ + C_QA + c), o0);
    unpack8(*(const u32x4*)(Z + row * LDZ + C_QA + 512 + c), o1);
    unpack8(*(const u32x4*)(Z + row * LDZ + C_QA + 1024 + c), o2);
    unpack8(*(const u32x4*)(Z + row * LDZ + C_GP + c), gp);
    float y[8];
#pragma unroll
    for (int e = 0; e < 8; ++e) y[e] = (e0 * o0[e] + e1 * o1[e] + e2 * o2[e]) * inv * siluf_(gp[e]);
    u32x4 o; o.x = pack2(y[0], y[1]); o.y = pack2(y[2], y[3]); o.z = pack2(y[4], y[5]); o.w = pack2(y[6], y[7]);
    *(u32x4*)(GATED + row * LDG + c) = o;
    float dv[8], dg[8];
    unpack8(*(const u32x4*)(GATED + row * LDG + 1536 + c), dv);
    unpack8(*(const u32x4*)(Z + row * LDZ + C_GP + 3 * 512 + c), dg);
    u32x4 od; od.x = pack2(dv[0] * siluf_(dg[0]), dv[1] * siluf_(dg[1])); od.y = pack2(dv[2] * siluf_(dg[2]), dv[3] * siluf_(dg[3]));
    od.z = pack2(dv[4] * siluf_(dg[4]), dv[5] * siluf_(dg[5])); od.w = pack2(dv[6] * siluf_(dg[6]), dv[7] * siluf_(dg[7]));
    *(u32x4*)(GATED + row * LDG + 1536 + c) = od;
  }
}

DI void phase_branchproj(const Params& p, int l, unsigned char* smem_) {
  const u16* Z = (const u16*)(p.ws + OFF_Z);
  const u16* GATED = (const u16*)(p.ws + OFF_GATED);
  const u16* WbT = (const u16*)(p.ws + OFF_WB) + (size_t)l * DM * LDG;
  u16* MERGED = (u16*)(p.ws + OFF_H);
  u16* smem = (u16*)smem_;
  const int tid = TIDX(), lane = tid & 63, w = tid >> 6, wm = w >> 1, wn = w & 1;
  constexpr bool PIPE = false;
  u16* sA = smem;
  u16* sB = smem + 2 * 8192;
  const int lr = tid >> 3, lc = (tid & 7) * 8;
  const int wsw = ((tid & 7) ^ ((lr >> 1) & 7)) * 8;
  const int rg = (lane & 15) >> 1, rq = lane >> 4;
  const int rs0 = (((rg >> 2) * 4) + (rq ^ (rg & 3))) * 8;
  const int rs1 = ((((rg >> 2) ^ 1) * 4) + (rq ^ (rg & 3))) * 8;
  for (int u = VB(); u < 8 * 128; u += VG()) {
    const int nt0 = u / 128, mt0 = u % 128;
    const u16* A = GATED + (size_t)mt0 * 128 * LDG;
    const u16* Bt = WbT + (size_t)nt0 * 128 * LDG;
    const int lda = LDG, ldb = LDG;
    f32x4 mer[4][4], acc[4][4];
    zero_acc(mer);
    zero_acc(acc);
    u32x4 r0a[4], r0b[4];
    G_LOAD(r0a, r0b, 0)
    __syncthreads();
    G_WRITE(r0a, r0b, 0)
    __syncthreads();
#pragma unroll 1
    for (int kt = 0; kt < 32; ++kt) {
      const int buf = kt & 1, g = kt >> 3;
      if (kt + 1 < 32) { G_LOAD(r0a, r0b, (kt + 1) * 64) }
      G_COMPUTE(buf)
      if (kt + 1 < 32) { G_WRITE(r0a, r0b, buf ^ 1) }
      __syncthreads();
      if ((kt & 7) == 7) {
#pragma unroll
        for (int mt = 0; mt < 4; ++mt)
#pragma unroll
          for (int nt = 0; nt < 4; ++nt) {
            const int row = mt0 * 128 + wm * 64 + mt * 16 + (lane & 15);
            const int col = nt0 * 128 + wn * 64 + nt * 16 + (lane >> 4) * 4;
            const u32x2 mg = *(const u32x2*)(Z + (size_t)row * LDZ + C_MG + g * 1024 + col);
            mer[mt][nt][0] += sigmoidf_(bflo(mg.x)) * acc[mt][nt][0];
            mer[mt][nt][1] += sigmoidf_(bfhi(mg.x)) * acc[mt][nt][1];
            mer[mt][nt][2] += sigmoidf_(bflo(mg.y)) * acc[mt][nt][2];
            mer[mt][nt][3] += sigmoidf_(bfhi(mg.y)) * acc[mt][nt][3];
            acc[mt][nt] = f32x4{0.f, 0.f, 0.f, 0.f};
          }
      }
    }
#pragma unroll
    for (int mt = 0; mt < 4; ++mt)
#pragma unroll
      for (int nt = 0; nt < 4; ++nt) {
        const int row = mt0 * 128 + wm * 64 + mt * 16 + (lane & 15);
        const int col = nt0 * 128 + wn * 64 + nt * 16 + (lane >> 4) * 4;
        u32x2 o; o.x = pack2(mer[mt][nt][0], mer[mt][nt][1]); o.y = pack2(mer[mt][nt][2], mer[mt][nt][3]);
        *(u32x2*)(MERGED + (size_t)row * LDH + col) = o;
      }
  }
}

DI void phase_outproj(const Params& p, int l, unsigned char* smem_base) {
  pg8::Gemm g; g.A = (const u16*)(p.ws + OFF_H); g.Bt = (const u16*)(p.ws + OFF_WO) + (size_t)l * DM * LDH; g.M = MTOK; g.N = DM; g.K = DM; g.ld = LDH;
  pg8::StaticOrder S; S.init(MTOK, DM, gridDim.x, blockIdx.x);
  pg8::EpiBf16 E; E.O = (u16*)(p.ws + OFF_OUT); E.ldc = DM;
  pg8::gemm_phase((PG8_LAS unsigned char*)smem_base, g, S, E);
}

DI void mix1_unit(const Params& p, const Bucket& bk, const SB& sb, int l, unsigned char* smem, int dry, int u) {
  const int nF = sb.B * sb.N1 * 8;
  const int nC = (MTOK / 64) * 4;
  const int nD = (MTOK / 64) * 4;
  int v = u;
  if (v < nF) { if (!dry || (PROBE_UNITS & 1)) { if (sb.N1 == 128) unit_fft1<128>(p, sb, v, smem); else unit_fft1<64>(p, sb, v, smem); } return; }
  v -= nF;
  if (v < nC) { if (!dry || (PROBE_UNITS & 2)) unit_mlstm_local(p, sb, l, v, smem); return; }
  v -= nC;
  if (v < nD) { if (!dry || (PROBE_UNITS & 4)) unit_attnD(p, sb, l, v, smem); return; }
  v -= nD;
  if (!dry || (PROBE_UNITS & 8)) unit_attnA(p, bk, sb, v, smem, dry);
}
DI void phase_mix1(const Params& p, const Bucket& bk, const SB& sb, int l, unsigned char* smem, int dry, unsigned* qhead, volatile unsigned* qslot) {
  const int nF = sb.B * sb.N1 * 8;
  const int tot = MTOK * 12 / 64 + nF + 2 * (MTOK / 64) * 4;
  if (qhead == nullptr) {
    for (int u = VB(); u < tot; u += VG()) mix1_unit(p, bk, sb, l, smem, dry, u);
    return;
  }
  const int half = HALF_ID();
  if (threadIdx.x == 0) *qslot = xb_add(qhead, 1u);
  __syncthreads();
  for (;;) {
    const int k = (int)*qslot;
    if (2 * k >= tot) break;
    unsigned nxt = 0u;
    if (threadIdx.x == 0) nxt = xb_add(qhead, 1u);
    const int pos = 2 * k + half;
    const int u = (pos < tot - nF) ? pos + nF : pos - (tot - nF);
    mix1_unit(p, bk, sb, l, smem, dry, u);
    __syncthreads();
    if (threadIdx.x == 0) *qslot = nxt;
    __syncthreads();
  }
}
DI void mix2_unit(const Params& p, const SB& sb, unsigned char* smem, int dry, int u) {
  const int nS = sb.B * 8 * 32, nA = MTOK / 16;
  int v = u;
  if (v < nS) { unit_mlstm_scan(p, sb, v, smem, dry); return; }
  v -= nS;
  if (v < nA) { unit_attn_combine(p, v); return; }
  v -= nA;
  if (sb.N1 == 128) unit_fft2<128>(p, sb, v, smem); else unit_fft2<64>(p, sb, v, smem);
}
DI void phase_mix2(const Params& p, const SB& sb, int l, unsigned char* smem, int dry, unsigned* qhead, volatile unsigned* qslot) {
  const int nF = sb.B * sb.N1 * 4;
  const int nS = sb.B * 8 * 32;
  const int nA = MTOK / 16;
  const int tot = nF + nS + nA;
  if (qhead == nullptr) {
    for (int u = VB(); u < tot; u += VG()) mix2_unit(p, sb, smem, dry, u);
    return;
  }
  const int half = HALF_ID();
  if (threadIdx.x == 0) *qslot = xb_add(qhead, 1u);
  __syncthreads();
  for (;;) {
    const int k = (int)*qslot;
    if (2 * k >= tot) break;
    unsigned nxt = 0u;
    if (threadIdx.x == 0) nxt = xb_add(qhead, 1u);
    const int pos = 2 * k + half;
    const int u = (pos < nS) ? pos : (pos < nS + nF ? pos + nA : pos - nF);
    mix2_unit(p, sb, smem, dry, u);
    __syncthreads();
    if (threadIdx.x == 0) *qslot = nxt;
    __syncthreads();
  }
}
DI void phase_mix3(const Params& p, const SB& sb, int l, unsigned char* smem) {
  const int nC = (MTOK / 64) * 4;
  for (int u = VB(); u < nC; u += VG()) unit_mlstm_out(p, sb, l, u, smem);
}

constexpr int STEPS_PER_SB = 4 * 7 + 1;
constexpr int N_STEPS = 2 + 3 * STEPS_PER_SB;

DI void run_step(const Params& p0, const Bucket& bk, int s, unsigned char* smem_base, int dry, bool coop, volatile unsigned* qslot) {
  Params p = p0;
  asm volatile("" : "+s"(p.ws));
  unsigned char* smem = smem_base + HALF_ID() * SMEM_HALF;
  if (s == 0) { phase_prep0(p, bk, smem); return; }
  int sbi, l, ph;
  if (coop) {
    if (s == 1) { phase_prep1(p, smem); const SB sb0 = get_sb(p, 0); phase_rows(p, sb0, 0, dry); return; }
    const int s2 = s - 2, r = s2 % 28; sbi = s2 / 28;
    if (r == 27) {
      const SB sbx = get_sb(p, sbi); phase_rows(p, sbx, 4, dry);
      if (sbi < 2) { const SB sbn = get_sb(p, sbi + 1); phase_rows(p, sbn, 0, dry); }
      return;
    }
    if (r < 6) { l = 0; ph = r + 1; } else { const int q = r - 6; l = 1 + q / 7; ph = q % 7; }
  } else {
    if (s == 1) { phase_prep1(p, smem); return; }
    const int s2 = s - 2, r = s2 % STEPS_PER_SB; sbi = s2 / STEPS_PER_SB;
    if (r == 28) { const SB sbx = get_sb(p, sbi); phase_rows(p, sbx, 4, dry); return; }
    l = r / 7; ph = r % 7;
  }
  const SB sb = get_sb(p, sbi);
  switch (ph) {
    case 0: phase_rows(p, sb, l, dry); break;
    case 1: phase_inproj(p, l, smem_base); break;
    case 2: phase_mix1(p, bk, sb, l, smem, dry, coop ? (unsigned*)(p.ws + OFF_BAR) + 4096 + (s & 127) : nullptr, qslot); break;
    case 3: phase_mix2(p, sb, l, smem, dry, coop ? (unsigned*)(p.ws + OFF_BAR) + 4096 + (s & 127) : nullptr, qslot); break;
    case 4: phase_mix3(p, sb, l, smem); break;
    case 5: phase_branchproj(p, l, smem); break;
    default: phase_outproj(p, l, smem_base); break;
  }
}

__global__ void __launch_bounds__(512, 2) mega_step(Params p, Bucket bk, int s, int dry) {
  extern __shared__ __attribute__((aligned(16))) unsigned char smem[];
  run_step(p, bk, s, smem, dry, false, nullptr);
}

__global__ void __launch_bounds__(512, 2) mega_coop(Params p, Bucket bk) {
  extern __shared__ __attribute__((aligned(16))) unsigned char smem[];
  __shared__ uint4 xb_words;
  cg::grid_group grid = cg::this_grid();
  if (p.ws == nullptr) grid.sync();
  if (threadIdx.x == 0) xb_words = make_uint4(0u, 0u, 0u, 0u);
  __syncthreads();
  (void)xcd_barrier_post((unsigned*)(p.ws + OFF_BAR), (volatile LAS unsigned*)&xb_words);
  constexpr int N_STEPS_COOP = 2 + 3 * 28;
#pragma unroll 1
  for (int s = 0; s < N_STEPS_COOP; ++s) {
    run_step(p, bk, s, smem, 0, true, (volatile unsigned*)&xb_words + 2);
    if (s + 1 < N_STEPS_COOP) {
      XcdBarrier xb; xb.bar = (unsigned*)(p.ws + OFF_BAR); xb.x = xb_xcc_id(); xb.st = (volatile LAS unsigned*)&xb_words;
      xcd_barrier(xb);
    }
  }
}

static int t5_bucket_host(int rel) {
  const int nb = 16, max_exact = 8;
  int ret = (rel > 0) ? nb : 0;
  int n = rel < 0 ? -rel : rel;
  int nn = n > 1 ? n : 1;
  int large = max_exact + (int)(std::log((double)nn / max_exact) / std::log(1024.0 / max_exact) * (nb - max_exact));
  if (large > nb - 1) large = nb - 1;
  return ret + (n < max_exact ? n : large);
}

extern "C" void kernel_launch(void* const* d_in, const int* in_sizes, int n_in, void* d_out, int out_size, void* d_ws,
                              size_t ws_size, hipStream_t stream) {
  Params p;
  memset(&p, 0, sizeof(p));
  p.x_prompt = (const float*)d_in[0]; p.x_sample = (const float*)d_in[1];
  p.mem_prompt = (const float*)d_in[2]; p.mem_sample = (const float*)d_in[3];
  p.rel_bias = (const float*)d_in[4]; p.norm_pre = (const float*)d_in[5]; p.w_in = (const float*)d_in[6];
  p.conv_qk = (const float*)d_in[7]; p.gate_bias = (const float*)d_in[8]; p.head_gain = (const float*)d_in[9];
  p.mem_norm = (const float*)d_in[10]; p.w_mem_kv = (const float*)d_in[11]; p.w_branch = (const float*)d_in[12];
  p.w_out = (const float*)d_in[13]; p.norm_post = (const float*)d_in[14];
  p.out = (float*)d_out;
  p.ws = (unsigned char*)d_ws;
  Bucket bk;
  memset(&bk, 0, sizeof(bk));
  const int dil[3] = {1, 4, 16};
  for (int g = 0; g < 3; ++g)
    for (int i = 0; i < 129; ++i) bk.b[g][i] = (unsigned char)t5_bucket_host(dil[g] * (i - 64));
  if (ws_size < WS_NEED) fprintf(stderr, "workspace too small: %zu < %zu\n", ws_size, (size_t)WS_NEED);

  static int grid_blocks = 0;
  if (!grid_blocks) {
    int dev = 0, cus = 0, per_cu = 0;
    hipGetDevice(&dev);
    hipDeviceGetAttribute(&cus, hipDeviceAttributeMultiprocessorCount, dev);
    hipFuncSetAttribute((const void*)mega_step, hipFuncAttributeMaxDynamicSharedMemorySize, SMEM_BYTES);
    hipFuncSetAttribute((const void*)mega_coop, hipFuncAttributeMaxDynamicSharedMemorySize, SMEM_BYTES);
    hipOccupancyMaxActiveBlocksPerMultiprocessor(&per_cu, mega_coop, 512, SMEM_BYTES);
    if (per_cu < 1) per_cu = 1;
    if (per_cu > 1) per_cu = 1;
    grid_blocks = cus * per_cu;
  }
#if MK_COOP
  hipMemsetAsync((unsigned char*)d_ws + OFF_BAR, 0, (4096 + 128) * sizeof(unsigned), stream);
  void* args[] = {&p, &bk};
  hipError_t e = hipLaunchCooperativeKernel((void*)mega_coop, dim3(grid_blocks), dim3(512), args, SMEM_BYTES, stream);
  if (e != hipSuccess) fprintf(stderr, "cooperative launch failed: %s (grid %d)\n", hipGetErrorString(e), grid_blocks);
#else
  for (int s = 0; s < N_STEPS; ++s) {
    if (PROBE_REPEAT > 0 && s >= 2 && ((s - 2) % STEPS_PER_SB) != 28 && ((PROBE_REPEAT >> (((s - 2) % STEPS_PER_SB) % 7)) & 1))
      hipLaunchKernelGGL(mega_step, dim3(grid_blocks), dim3(512), SMEM_BYTES, stream, p, bk, s, 1);
    hipLaunchKernelGGL(mega_step, dim3(grid_blocks), dim3(512), SMEM_BYTES, stream, p, bk, s, 0);
  }
#endif
}
```

```cpp
#include <hip/hip_runtime.h>
#include <hip/hip_cooperative_groups.h>
#include <cstdio>
#include <cstring>
#include <cmath>
namespace cg = cooperative_groups;

#ifndef MK_COOP
#define MK_COOP 1
#endif
#ifndef PROBE_UNITS
#define PROBE_UNITS 15
#endif
#ifndef PROBE_REPEAT
#define PROBE_REPEAT 0
#endif

typedef unsigned short u16;
using bf16x8 = __attribute__((ext_vector_type(8))) short;
using s16x4 = __attribute__((ext_vector_type(4))) short;
using f32x4 = __attribute__((ext_vector_type(4))) float;
using u32x4 = __attribute__((ext_vector_type(4))) unsigned;
using u32x2 = __attribute__((ext_vector_type(2))) unsigned;
#define DI __device__ __forceinline__

constexpr int DM = 1024;
constexpr int LDZ = 14080;
constexpr int NORIG = 13840;
constexpr int C_QA = 0, C_KA = 1536, C_VA = 3072, C_XB = 4608, C_QC = 5120, C_KC = 5632, C_VC = 6144, C_OC = 6656,
              C_QD = 7168, C_GP = 7680, C_MG = 9728, C_GC = 13824;
constexpr int LDH = 1088;
constexpr int LDG = 2112;
constexpr int MTOK = 16384;
constexpr float EPSV = 1e-6f;
constexpr float QSCALE = 0.08838834764831845f;
constexpr int SMEM_HALF = 75776;
constexpr int SMEM_BYTES = 2 * SMEM_HALF;

constexpr size_t OFF_WIN = 0;
constexpr size_t OFF_WB = OFF_WIN + (size_t)4 * LDZ * LDH * 2;
constexpr size_t OFF_WO = OFF_WB + (size_t)4 * 1024 * LDG * 2;
constexpr size_t OFF_KVK = OFF_WO + (size_t)4 * 1024 * LDH * 2;
constexpr size_t OFF_KVV = OFF_KVK + 6291456;
constexpr size_t OFF_DFT = OFF_KVV + 6291456;
constexpr size_t OFF_H = OFF_DFT + 131072;
constexpr size_t OFF_GATED = OFF_H + (size_t)16384 * LDH * 2;
constexpr size_t OFF_LSE = OFF_GATED + (size_t)16384 * LDG * 2;
constexpr size_t OFF_OUT = OFF_LSE + 786432;
constexpr size_t OFF_CS = OFF_OUT + 67108864;
constexpr size_t OFF_NS = OFF_CS + 67108864;
constexpr size_t OFF_SC = OFF_NS + 1048576;
constexpr size_t OFF_BAR = OFF_SC + 32768;
constexpr size_t OFF_Z = OFF_SC + 65536;
constexpr size_t OFF_WKV = OFF_Z;
constexpr size_t OFF_HM = OFF_Z + (size_t)4 * 1024 * LDH * 2;
constexpr size_t WS_NEED = OFF_Z + (size_t)16384 * LDZ * 2;

struct Params {
  const float *x_prompt, *x_sample, *mem_prompt, *mem_sample, *rel_bias, *norm_pre, *w_in, *conv_qk, *gate_bias,
      *head_gain, *mem_norm, *w_mem_kv, *w_branch, *w_out, *norm_post;
  float* out;
  unsigned char* ws;
};
struct Bucket { unsigned char b[3][136]; };

DI int TIDX() { int t = threadIdx.x & 255; asm volatile("" : "+v"(t)); return t; }
DI int HALF_ID() { return __builtin_amdgcn_readfirstlane((int)(threadIdx.x >> 8)); }
DI int VB() { return (int)blockIdx.x * 2 + HALF_ID(); }
DI int VG() { return (int)gridDim.x * 2; }
DI u16 f2bf(float x) { unsigned u = __float_as_uint(x); u += 0x7fffu + ((u >> 16) & 1u); return (u16)(u >> 16); }
DI float bf2f(u16 h) { return __uint_as_float(((unsigned)h) << 16); }
DI float bflo(unsigned u) { return __uint_as_float(u << 16); }
DI float bfhi(unsigned u) { return __uint_as_float(u & 0xffff0000u); }
DI unsigned pack2(float a, float b) { return (unsigned)f2bf(a) | ((unsigned)f2bf(b) << 16); }
DI f32x4 mfma16(bf16x8 a, bf16x8 b, f32x4 c) { return __builtin_amdgcn_mfma_f32_16x16x32_bf16(a, b, c, 0, 0, 0); }
DI bf16x8 ldfrag(const u16* p) { return *reinterpret_cast<const bf16x8*>(p); }
DI float wsum(float v) { for (int o = 32; o; o >>= 1) v += __shfl_xor(v, o); return v; }
DI float wmaxr(float v) { for (int o = 32; o; o >>= 1) v = fmaxf(v, __shfl_xor(v, o)); return v; }
DI float sigmoidf_(float x) { return __builtin_amdgcn_rcpf(1.f + __expf(-x)); }
DI float siluf_(float x) { return x * __builtin_amdgcn_rcpf(1.f + __expf(-x)); }
DI float logsigf_(float x) { return fminf(x, 0.f) - log1pf(__expf(-fabsf(x))); }
DI void unpack8(u32x4 v, float (&f)[8]) {
  f[0] = bflo(v.x); f[1] = bfhi(v.x); f[2] = bflo(v.y); f[3] = bfhi(v.y);
  f[4] = bflo(v.z); f[5] = bfhi(v.z); f[6] = bflo(v.w); f[7] = bfhi(v.w);
}
DI bf16x8 negfrag(bf16x8 a) {
  bf16x8 r;
#pragma unroll
  for (int j = 0; j < 8; ++j) r[j] = (short)(a[j] ^ (short)0x8000);
  return r;
}


#define XB_TMO      128
#define XB_XCNT(j)  (256  + 64 * (j))
#define XB_XSUB(j)  (1280 + 64 * (j))
#define XB_XGEN(j)  (2304 + 64 * (j))
#define XB_TOP      3328
#define XB_TOPGEN   3392
#define XCD_BAR_WORDS 3456
#define XB_SPIN_CAP (1u << 22)
#define LAS __attribute__((address_space(3)))
DI unsigned xb_ld(unsigned* p) { return __hip_atomic_load(p, __ATOMIC_RELAXED, __HIP_MEMORY_SCOPE_AGENT); }
DI unsigned xb_add(unsigned* p, unsigned v) { return __hip_atomic_fetch_add(p, v, __ATOMIC_RELAXED, __HIP_MEMORY_SCOPE_AGENT); }
DI unsigned xb_xcc_id() { return (unsigned)__builtin_amdgcn_s_getreg((3 << 11) | 20) & 0xFu; }
#define XB_SPIN(cond, bar) do { unsigned _sp = 0; while (cond) { __builtin_amdgcn_s_sleep(1); \
    if ((++_sp & 255u) == 0u) { if (xb_ld(&(bar)[XB_TMO])) break; if (_sp > XB_SPIN_CAP) { atomicAdd(&(bar)[XB_TMO], 1u); break; } } } } while (0)
struct XcdBarrier { unsigned* bar; unsigned x; volatile LAS unsigned* st; };
DI XcdBarrier xcd_barrier_post(unsigned* bar, volatile LAS unsigned* st) {
  XcdBarrier b; b.bar = bar; b.x = xb_xcc_id(); b.st = st;
  if (threadIdx.x == 0) (void)xb_add(&bar[XB_XCNT(b.x)], 1u);
  return b;
}
DI void xcd_barrier_complete(unsigned* bar, unsigned x, unsigned& nloc, unsigned& nx) {
  const unsigned G = gridDim.x * gridDim.y * gridDim.z;
  unsigned sum, cnt, mine, sp = 0u;
  for (;;) {
    sum = 0u; cnt = 0u; mine = 0u;
#pragma unroll
    for (unsigned j = 0; j < 16; ++j) { const unsigned c = xb_ld(&bar[XB_XCNT(j)]); sum += c; cnt += (c > 0u) ? 1u : 0u; mine = (j == x) ? c : mine; }
    if (sum == G) break;
    __builtin_amdgcn_s_sleep(1);
    if ((++sp & 255u) == 0u) { if (xb_ld(&bar[XB_TMO])) break; if (sp > XB_SPIN_CAP) { atomicAdd(&bar[XB_TMO], 1u); break; } }
  }
  nloc = mine > 0u ? mine : 1u; nx = cnt > 0u ? cnt : 1u;
}
DI void xcd_barrier(const XcdBarrier& b) {
  asm volatile("s_waitcnt vmcnt(0)" ::: "memory");
  __syncthreads();
  if (threadIdx.x == 0) {
    unsigned* bar = b.bar;
    __builtin_amdgcn_s_waitcnt(0);
    unsigned nloc = b.st[0], nx = b.st[1];
    if (nloc == 0u) { xcd_barrier_complete(bar, b.x, nloc, nx); b.st[0] = nloc; b.st[1] = nx; }
    const unsigned old = xb_add(&bar[XB_XSUB(b.x)], 1u);
    const unsigned gen = old / nloc;
    if (old + 1u == (gen + 1u) * nloc) {
      __builtin_amdgcn_fence(__ATOMIC_RELEASE, "agent");
      asm volatile("s_waitcnt vmcnt(0)" ::: "memory");
      const unsigned og = xb_add(&bar[XB_TOP], 1u);
      const unsigned tg = og / nx;
      if (og + 1u == (tg + 1u) * nx) xb_add(&bar[XB_TOPGEN], 1u);
      else XB_SPIN(xb_ld(&bar[XB_TOPGEN]) == tg, bar);
      __builtin_amdgcn_fence(__ATOMIC_ACQUIRE, "agent");
      xb_add(&bar[XB_XGEN(b.x)], 1u);
      asm volatile("s_waitcnt vmcnt(0)" ::: "memory");
    } else {
      XB_SPIN(xb_ld(&bar[XB_XGEN(b.x)]) == gen, bar);
      __builtin_amdgcn_fence(__ATOMIC_ACQUIRE, "agent");
      asm volatile("s_waitcnt vmcnt(0)" ::: "memory");
    }
  }
  __syncthreads();
}

struct SB {
  const float* xin; float* xout; int B, L, memb, N1;
};
DI SB get_sb(const Params& p, int sb) {
  SB s;
  if (sb < 2) { s.xin = p.x_sample + (size_t)sb * MTOK * DM; s.xout = p.out + (size_t)(MTOK + sb * MTOK) * DM; s.B = 1; s.L = 16384; s.memb = 4 + sb; s.N1 = 128; }
  else { s.xin = p.x_prompt; s.xout = p.out; s.B = 4; s.L = 4096; s.memb = 0; s.N1 = 64; }
  return s;
}

#define G_LOAD(RA, RB, K0) _Pragma("unroll") for (int i = 0; i < 4; ++i) { \
    RA[i] = *(const u32x4*)(A + (size_t)(lr + 32 * i) * lda + (K0) + lc); RB[i] = *(const u32x4*)(Bt + (size_t)(lr + 32 * i) * ldb + (K0) + lc); }
#define G_WRITE(RA, RB, BUF) _Pragma("unroll") for (int i = 0; i < 4; ++i) { \
    *(u32x4*)(sA + (BUF) * 8192 + (lr + 32 * i) * 64 + wsw) = RA[i]; *(u32x4*)(sB + (BUF) * 8192 + (lr + 32 * i) * 64 + wsw) = RB[i]; }
#define G_COMPUTE(BUF) { \
    const u16* a0 = sA + (BUF) * 8192 + (wm * 64 + (lane & 15)) * 64; \
    const u16* b0 = sB + (BUF) * 8192 + (wn * 64 + (lane & 15)) * 64; \
    if (PIPE) { \
      bf16x8 a[2][4], b[2][4]; \
      _Pragma("unroll") for (int t = 0; t < 4; ++t) { a[0][t] = ldfrag(a0 + t * 1024 + rs0); b[0][t] = ldfrag(b0 + t * 1024 + rs0); } \
      _Pragma("unroll") for (int t = 0; t < 4; ++t) { a[1][t] = ldfrag(a0 + t * 1024 + rs1); b[1][t] = ldfrag(b0 + t * 1024 + rs1); } \
      __builtin_amdgcn_sched_barrier(0); \
      _Pragma("unroll") for (int ks = 0; ks < 2; ++ks) \
        _Pragma("unroll") for (int mt = 0; mt < 4; ++mt) _Pragma("unroll") for (int nt = 0; nt < 4; ++nt) acc[mt][nt] = mfma16(b[ks][nt], a[ks][mt], acc[mt][nt]); \
      __builtin_amdgcn_sched_barrier(0); \
    } else { \
      _Pragma("unroll") for (int ks = 0; ks < 2; ++ks) { \
        bf16x8 a[4], b[4]; \
        _Pragma("unroll") for (int t = 0; t < 4; ++t) { a[t] = ldfrag(a0 + t * 1024 + (ks ? rs1 : rs0)); b[t] = ldfrag(b0 + t * 1024 + (ks ? rs1 : rs0)); } \
        _Pragma("unroll") for (int mt = 0; mt < 4; ++mt) _Pragma("unroll") for (int nt = 0; nt < 4; ++nt) acc[mt][nt] = mfma16(b[nt], a[mt], acc[mt][nt]); } } }
template <bool DEEP, bool PIPE>
DI void gemm_acc(f32x4 (&acc)[4][4], const u16* __restrict__ A, int lda, const u16* __restrict__ Bt, int ldb, int nk, u16* smem) {
  const int tid = TIDX(), lane = tid & 63, w = tid >> 6, wm = w >> 1, wn = w & 1;
  u16* sA = smem;
  u16* sB = smem + 2 * 8192;
  const int lr = tid >> 3, lc = (tid & 7) * 8;
  const int wsw = ((tid & 7) ^ ((lr >> 1) & 7)) * 8;
  const int rg = (lane & 15) >> 1, rq = lane >> 4;
  const int rs0 = (((rg >> 2) * 4) + (rq ^ (rg & 3))) * 8;
  const int rs1 = ((((rg >> 2) ^ 1) * 4) + (rq ^ (rg & 3))) * 8;
  u32x4 r0a[4], r0b[4];
  G_LOAD(r0a, r0b, 0)
  if (DEEP) {
    u32x4 r1a[4], r1b[4];
    G_LOAD(r1a, r1b, 64)
    __syncthreads();
    G_WRITE(r0a, r0b, 0)
    __syncthreads();
    if (2 < nk) { G_LOAD(r0a, r0b, 128) }
#pragma unroll 1
    for (int kt = 0; kt < nk; kt += 2) {
      G_COMPUTE(0)
      if (kt + 1 < nk) { G_WRITE(r1a, r1b, 1) }
      if (kt + 3 < nk) { G_LOAD(r1a, r1b, (kt + 3) * 64) }
      __syncthreads();
      if (kt + 1 >= nk) break;
      G_COMPUTE(1)
      if (kt + 2 < nk) { G_WRITE(r0a, r0b, 0) }
      if (kt + 4 < nk) { G_LOAD(r0a, r0b, (kt + 4) * 64) }
      __syncthreads();
    }
  } else {
    __syncthreads();
    G_WRITE(r0a, r0b, 0)
    __syncthreads();
#pragma unroll 1
    for (int kt = 0; kt < nk; ++kt) {
      const int buf = kt & 1;
      if (kt + 1 < nk) { G_LOAD(r0a, r0b, (kt + 1) * 64) }
      G_COMPUTE(buf)
      if (kt + 1 < nk) { G_WRITE(r0a, r0b, buf ^ 1) }
      __syncthreads();
    }
  }
}

#define G_READ(F_A, F_B, BUF, RS) { \
    const u16* a0 = sA + (BUF) * 8192 + (wm * 64 + (lane & 15)) * 64 + (RS); \
    const u16* b0 = sB + (BUF) * 8192 + (wn * 64 + (lane & 15)) * 64 + (RS); \
    _Pragma("unroll") for (int t = 0; t < 4; ++t) { F_A[t] = ldfrag(a0 + t * 1024); F_B[t] = ldfrag(b0 + t * 1024); } }
#define G_MMA(F_A, F_B) { \
    _Pragma("unroll") for (int mt = 0; mt < 4; ++mt) _Pragma("unroll") for (int nt = 0; nt < 4; ++nt) acc[mt][nt] = mfma16(F_B[nt], F_A[mt], acc[mt][nt]); }
DI void gemm_acc_sp(f32x4 (&acc)[4][4], const u16* __restrict__ A, int lda, const u16* __restrict__ Bt, int ldb, int nk, u16* smem) {
  const int tid = TIDX(), lane = tid & 63, w = tid >> 6, wm = w >> 1, wn = w & 1;
  u16* sA = smem;
  u16* sB = smem + 2 * 8192;
  const int lr = tid >> 3, lc = (tid & 7) * 8;
  const int wsw = ((tid & 7) ^ ((lr >> 1) & 7)) * 8;
  const int rg = (lane & 15) >> 1, rq = lane >> 4;
  const int rs0 = (((rg >> 2) * 4) + (rq ^ (rg & 3))) * 8;
  const int rs1 = ((((rg >> 2) ^ 1) * 4) + (rq ^ (rg & 3))) * 8;
  u32x4 r0a[4], r0b[4];
  bf16x8 fa0[4], fb0[4], fa1[4], fb1[4];
  G_LOAD(r0a, r0b, 0)
  __syncthreads();
  G_WRITE(r0a, r0b, 0)
  __syncthreads();
  if (1 < nk) { G_LOAD(r0a, r0b, 64) }
  G_READ(fa0, fb0, 0, rs0)
#pragma unroll 1
  for (int kt = 0; kt < nk; ++kt) {
    const int buf = kt & 1;
    G_READ(fa1, fb1, buf, rs1)
    __builtin_amdgcn_sched_barrier(0);
    G_MMA(fa0, fb0)
    __builtin_amdgcn_sched_barrier(0);
    if (kt + 1 < nk) { G_WRITE(r0a, r0b, buf ^ 1) }
    if (kt + 2 < nk) { G_LOAD(r0a, r0b, (kt + 2) * 64) }
    __syncthreads();
    if (kt + 1 < nk) { G_READ(fa0, fb0, buf ^ 1, rs0) }
    __builtin_amdgcn_sched_barrier(0);
    G_MMA(fa1, fb1)
    __builtin_amdgcn_sched_barrier(0);
  }
}
DI void zero_acc(f32x4 (&acc)[4][4]) {
#pragma unroll
  for (int a = 0; a < 4; ++a)
#pragma unroll
    for (int b = 0; b < 4; ++b) acc[a][b] = f32x4{0.f, 0.f, 0.f, 0.f};
}

DI int win_orig_col(int n) { return n < 7168 ? n : (n < 13824 ? n + 16 : (n < 13840 ? n - 13824 + 7168 : -1)); }

template <bool WINMAP>
DI void transpose_tile(const float* __restrict__ src, size_t src_ld, u16* __restrict__ dst, size_t dst_ld, int r0, int c0, float* sT) {
  const int tid = TIDX();
  __syncthreads();
#pragma unroll 4
  for (int i = 0; i < 16; ++i) {
    const int r = i * 4 + (tid >> 6), c = tid & 63;
    int sc = c0 + c;
    if (WINMAP) sc = win_orig_col(sc);
    sT[r * 65 + c] = (sc >= 0) ? src[(size_t)(r0 + r) * src_ld + sc] : 0.f;
  }
  __syncthreads();
#pragma unroll 4
  for (int i = 0; i < 16; ++i) {
    const int c = i * 4 + (tid >> 6), r = tid & 63;
    dst[(size_t)(c0 + c) * dst_ld + r0 + r] = f2bf(sT[r * 65 + c]);
  }
}

DI void phase_prep0(const Params& p, const Bucket& bk, unsigned char* smem) {
  float* sT = (float*)smem;
  u16* WinT = (u16*)(p.ws + OFF_WIN);
  u16* WbT = (u16*)(p.ws + OFF_WB);
  u16* WoT = (u16*)(p.ws + OFF_WO);
  u16* WkvT = (u16*)(p.ws + OFF_WKV);
  u16* HM = (u16*)(p.ws + OFF_HM);
  u16* DFT = (u16*)(p.ws + OFF_DFT);
  constexpr int U_WIN = 4 * 220 * 16, U_WB = 4 * 4 * 8 * 16, U_WO = 4 * 16 * 16, U_WKV = 4 * 16 * 16, U_HM = 1536, U_DFT = 160, U_BT = 8;
  constexpr int TOT = U_WIN + U_WB + U_WO + U_WKV + U_HM + U_DFT + U_BT;
  const int tid = TIDX(), lane = tid & 63, w = tid >> 6;
  for (int u = VB(); u < TOT; u += VG()) {
    int v = u;
    if (v < U_WIN) {
      const int l = v / (220 * 16), r = v % (220 * 16), nt = r / 16, kt = r % 16;
      transpose_tile<true>(p.w_in + (size_t)l * DM * NORIG, NORIG, WinT + (size_t)l * LDZ * LDH, LDH, kt * 64, nt * 64, sT);
      continue;
    }
    v -= U_WIN;
    if (v < U_WB) {
      const int l = v / 512, r = v % 512, g = r / 128, r2 = r % 128, ct = r2 / 16, dt = r2 % 16;
      transpose_tile<false>(p.w_branch + ((size_t)(l * 4 + g) * 512) * DM, DM, WbT + (size_t)l * DM * LDG + g * 512, LDG, ct * 64, dt * 64, sT);
      continue;
    }
    v -= U_WB;
    if (v < U_WO) {
      const int l = v / 256, r = v % 256, kt = r / 16, nt = r % 16;
      transpose_tile<false>(p.w_out + (size_t)l * DM * DM, DM, WoT + (size_t)l * DM * LDH, LDH, kt * 64, nt * 64, sT);
      continue;
    }
    v -= U_WO;
    if (v < U_WKV) {
      const int l = v / 256, r = v % 256, kt = r / 16, nt = r % 16;
      transpose_tile<false>(p.w_mem_kv + (size_t)l * DM * DM, DM, WkvT + (size_t)l * DM * LDH, LDH, kt * 64, nt * 64, sT);
      continue;
    }
    v -= U_WKV;
    if (v < U_HM) {
      const int row = v;
      if (w == 0) {
        const float* src = (row < 1024) ? p.mem_prompt + (size_t)row * DM : p.mem_sample + (size_t)(row - 1024) * DM;
        float4 xv[4];
        float ss = 0.f;
#pragma unroll
        for (int i = 0; i < 4; ++i) { xv[i] = *(const float4*)(src + (i * 64 + lane) * 4); ss += xv[i].x * xv[i].x + xv[i].y * xv[i].y + xv[i].z * xv[i].z + xv[i].w * xv[i].w; }
        ss = wsum(ss);
        const float rstd = rsqrtf(ss * (1.f / DM) + EPSV);
        for (int l = 0; l < 4; ++l) {
#pragma unroll
          for (int i = 0; i < 4; ++i) {
            const float4 g = *(const float4*)(p.mem_norm + l * DM + (i * 64 + lane) * 4);
            u32x2 o; o.x = pack2(xv[i].x * rstd * g.x, xv[i].y * rstd * g.y); o.y = pack2(xv[i].z * rstd * g.z, xv[i].w * rstd * g.w);
            *(u32x2*)(HM + ((size_t)l * 1536 + row) * LDH + (i * 64 + lane) * 4) = o;
          }
        }
      }
      continue;
    }
    v -= U_HM;
    if (v >= U_DFT) {
      const int e = (v - U_DFT) * 256 + tid;
      if (e < 3 * 4 * 129) {
        const int gh = e / 129, i = e % 129, g = gh >> 2;
        ((float*)(p.ws + OFF_DFT + 98304))[e] = p.rel_bias[(int)bk.b[g][i] * 12 + gh];
      }
      continue;
    }
    {
      const int e = v * 256 + tid;
      if (e < 40960) {
        int N, idx, isS;
        if (e < 32768) { N = 128; isS = e >= 16384; idx = e & 16383; }
        else { N = 64; isS = (e - 32768) >= 4096; idx = (e - 32768) & 4095; }
        const int i = idx / N, j = idx % N;
        const float a = 2.f * (float)((i * j) % N) / (float)N;
        DFT[e] = f2bf(isS ? sinpif(a) : cospif(a));
      }
    }
  }
}

DI void phase_prep1(const Params& p, unsigned char* smem) {
  const u16* WkvT = (const u16*)(p.ws + OFF_WKV);
  const u16* HM = (const u16*)(p.ws + OFF_HM);
  u16* KVK = (u16*)(p.ws + OFF_KVK);
  u16* KVV = (u16*)(p.ws + OFF_KVV);
  const int tid = TIDX(), lane = tid & 63, w = tid >> 6, wm = w >> 1, wn = w & 1;
  for (int u = VB(); u < 4 * 12 * 8; u += VG()) {
    const int l = u / 96, r = u % 96, mt0 = r / 8, nt0 = r % 8;
    f32x4 acc[4][4];
    zero_acc(acc);
    gemm_acc<false, true>(acc, HM + ((size_t)l * 1536 + mt0 * 128) * LDH, LDH, WkvT + ((size_t)l * DM + nt0 * 128) * LDH, LDH, 16, (u16*)smem);
#pragma unroll
    for (int mt = 0; mt < 4; ++mt)
#pragma unroll
      for (int nt = 0; nt < 4; ++nt)
#pragma unroll
        for (int i = 0; i < 4; ++i) {
          const int row = mt0 * 128 + wm * 64 + mt * 16 + (lane & 15);
          const int col = nt0 * 128 + wn * 64 + nt * 16 + (lane >> 4) * 4 + i;
          const int b = row >> 8, m = row & 255;
          const int sel = col >> 9, h = (col >> 7) & 3, c = col & 127;
          const u16 val = f2bf(acc[mt][nt][i]);
          const size_t base = ((size_t)(l * 6 + b) * 4 + h) * 256 * 128;
          if (sel == 0) KVK[base + m * 128 + c] = val;
          else KVV[base + c * 256 + m] = val;
        }
  }
}

DI void phase_rows(const Params& p, const SB& sb, int l, int dry) {
  const u16* OUTB = (const u16*)(p.ws + OFF_OUT);
  u16* H = (u16*)(p.ws + OFF_H);
  const int tid = TIDX(), lane = tid & 63, w = tid >> 6;
  for (int row = VB() * 4 + w; row < MTOK; row += VG() * 4) {
    float4 xv[4];
    if (l == 0) {
#pragma unroll
      for (int i = 0; i < 4; ++i) xv[i] = *(const float4*)(sb.xin + (size_t)row * DM + (i * 64 + lane) * 4);
    } else {
      const float* xp = (l == 1 ? sb.xin : sb.xout) + (size_t)row * DM;
      float4 ov[4];
      float ss = 0.f;
#pragma unroll
      for (int i = 0; i < 4; ++i) { const u32x2 ob = *(const u32x2*)(OUTB + (size_t)row * DM + (i * 64 + lane) * 4);
        ov[i].x = bflo(ob.x); ov[i].y = bfhi(ob.x); ov[i].z = bflo(ob.y); ov[i].w = bfhi(ob.y);
        ss += ov[i].x * ov[i].x + ov[i].y * ov[i].y + ov[i].z * ov[i].z + ov[i].w * ov[i].w; }
      ss = wsum(ss);
      const float rstd = rsqrtf(ss * (1.f / DM) + EPSV);
#pragma unroll
      for (int i = 0; i < 4; ++i) {
        const float4 g = *(const float4*)(p.norm_post + (l - 1) * DM + (i * 64 + lane) * 4);
        const float4 xo = *(const float4*)(xp + (i * 64 + lane) * 4);
        xv[i].x = xo.x + ov[i].x * rstd * g.x; xv[i].y = xo.y + ov[i].y * rstd * g.y;
        xv[i].z = xo.z + ov[i].z * rstd * g.z; xv[i].w = xo.w + ov[i].w * rstd * g.w;
        if (!dry) *(float4*)(sb.xout + (size_t)row * DM + (i * 64 + lane) * 4) = xv[i];
      }
    }
    if (l < 4) {
      float ss = 0.f;
#pragma unroll
      for (int i = 0; i < 4; ++i) ss += xv[i].x * xv[i].x + xv[i].y * xv[i].y + xv[i].z * xv[i].z + xv[i].w * xv[i].w;
      ss = wsum(ss);
      const float rstd = rsqrtf(ss * (1.f / DM) + EPSV);
#pragma unroll
      for (int i = 0; i < 4; ++i) {
        const float4 g = *(const float4*)(p.norm_pre + l * DM + (i * 64 + lane) * 4);
        u32x2 o; o.x = pack2(xv[i].x * rstd * g.x, xv[i].y * rstd * g.y); o.y = pack2(xv[i].z * rstd * g.z, xv[i].w * rstd * g.w);
        *(u32x2*)(H + (size_t)row * LDH + (i * 64 + lane) * 4) = o;
      }
    }
  }
}

namespace pg8 {
#define PG8_LAS __attribute__((address_space(3)))
constexpr int BM = 256, BK = 64, HALF = 128, HTB = HALF * BK * 2, STAGE_BYTES = 8 * HTB, NXCD = 8, WGM = 8;
DI int lds_byte(int r, int c) { const int st = (r >> 4) * 2 + (c >> 5), rr = r & 15, cc = c & 31, ob = rr * 64 + cc * 2; return st * 1024 + (ob ^ (((ob >> 9) & 1) << 5)); }
DI void stage_rc(int b, int& R, int& C) { const int st = b / 1024, sb = b % 1024, swz = sb ^ (((sb >> 9) & 1) << 5); R = (st >> 1) * 16 + swz / 64; C = (st & 1) * 32 + (swz % 64) / 2; }
DI int perm32(int rho) { const int n = rho >> 4, i = rho & 15; return 8 * (i >> 2) + 4 * n + (i & 3); }
struct Unit { int pm, pn; };
struct Gemm { const u16* A; const u16* Bt; int M, N, K, ld; };
struct StaticOrder {
  int nM, nN, nwg, G, c;
  DI void init(int M, int N, int G_, int c_) { nM = M / BM; nN = N / BM; nwg = nM * nN; G = G_; c = c_; }
  DI bool next(int i, Unit& u) const {
    const long L = (long)i * G + c; if (L >= nwg) return false;
    int wgid = (int)L; { const int q = nwg / NXCD, r = nwg % NXCD, xcd = wgid % NXCD, off = wgid / NXCD; wgid = (xcd < r ? xcd * (q + 1) : r * (q + 1) + (xcd - r) * q) + off; }
    const int nig = WGM * nN, gid = wgid / nig, fm = gid * WGM, gsz = (nM - fm) < WGM ? (nM - fm) : WGM;
    u.pm = fm + ((wgid % nig) % gsz); u.pn = (wgid % nig) / gsz; return true;
  }
};
DI unsigned cvt_pk_bf16(float lo, float hi) { unsigned r; asm volatile("v_cvt_pk_bf16_f32 %0, %1, %2" : "=v"(r) : "v"(lo), "v"(hi)); return r; }
struct EpiF32 {
  static constexpr bool PERM = false;
  float* C; int ldc;
  DI void operator()(const f32x4 (&acc)[2][2][4][2], const Unit& u, int wr, int wc, int fr, int fq) const {
    const int row0 = u.pm * BM + wr * 64 + fr, col0 = u.pn * BM + wc * 32 + 4 * fq;
#pragma unroll
    for (int ai = 0; ai < 2; ++ai)
#pragma unroll
      for (int m = 0; m < 4; ++m) { float* rowp = C + (size_t)(row0 + ai * HALF + m * 16) * ldc + col0;
#pragma unroll
        for (int bj = 0; bj < 2; ++bj)
#pragma unroll
          for (int n = 0; n < 2; ++n) *(f32x4*)(rowp + bj * HALF + n * 16) = acc[ai][bj][m][n]; }
  }
};
struct EpiBf16 {
  static constexpr bool PERM = true;
  u16* O; int ldc;
  DI void operator()(const f32x4 (&acc)[2][2][4][2], const Unit& u, int wr, int wc, int fr, int fq) const {
    const int row0 = u.pm * BM + wr * 64 + fr, col0 = u.pn * BM + wc * 32 + 8 * fq;
#pragma unroll
    for (int ai = 0; ai < 2; ++ai)
#pragma unroll
      for (int m = 0; m < 4; ++m) { u16* rowp = O + (size_t)(row0 + ai * HALF + m * 16) * ldc + col0;
#pragma unroll
        for (int bj = 0; bj < 2; ++bj) { const f32x4 v0 = acc[ai][bj][m][0], v1 = acc[ai][bj][m][1];
          u32x4 w; w.x = cvt_pk_bf16(v0[0], v0[1]); w.y = cvt_pk_bf16(v0[2], v0[3]); w.z = cvt_pk_bf16(v1[0], v1[1]); w.w = cvt_pk_bf16(v1[2], v1[3]);
          *(u32x4*)(rowp + bj * HALF) = w; } }
  }
};
template <class Epi, class Sched>
DI void gemm_phase(PG8_LAS unsigned char* lds, const Gemm g, const Sched& S, const Epi& E) {
  int tid = threadIdx.x; asm volatile("" : "+v"(tid));
  const int wid = __builtin_amdgcn_readfirstlane(tid >> 6), lane = tid & 63, wr = wid >> 2, wc = wid & 3, fr = lane & 15, fq = lane >> 4;
  const int K = g.K, nt = K / BK, ld = g.ld;
  unsigned voffA[2], voffB[2];
#pragma unroll
  for (int i = 0; i < 2; ++i) { int R, C; stage_rc(tid * 16 + i * 8192, R, C); const int Rb = Epi::PERM ? ((R & ~31) + perm32(R & 31)) : R;
    voffA[i] = (unsigned)(R * ld + C) * 2u; voffB[i] = (unsigned)(Rb * ld + C) * 2u; }
  const size_t kstep = (size_t)(BK * 2);
  const size_t hstep = (size_t)HALF * ld * 2;
  const size_t tstep = 2 * hstep;
  const unsigned ldsw = (unsigned)wid * 1024u;
  const int aoff = lds_byte(wr * 64 + fr, fq * 8), boff = lds_byte(wc * 32 + fr, fq * 8);
#define PG8_SA(b, h) (((b) * 2 + (h)) * HTB)
#define PG8_SB(b, h) ((4 + (b) * 2 + (h)) * HTB)
#define PG8_STAGE(bufoff, gbase, voff) do { _Pragma("unroll") for (int _i = 0; _i < 2; ++_i) \
    __builtin_amdgcn_global_load_lds((const unsigned*)((const char*)(gbase) + (voff)[_i]), (PG8_LAS unsigned*)(lds + (bufoff) + ldsw + _i * 8192), 16, 0, 0); } while (0)
#define PG8_LDA(dst, b, h) do { _Pragma("unroll") for (int m = 0; m < 4; ++m) _Pragma("unroll") for (int k = 0; k < 2; ++k) dst[m][k] = *(const PG8_LAS bf16x8*)(lds + PG8_SA(b, h) + aoff + m * 2048 + k * 1024); } while (0)
#define PG8_LDB(dst, b, h) do { _Pragma("unroll") for (int n = 0; n < 2; ++n) _Pragma("unroll") for (int k = 0; k < 2; ++k) dst[n][k] = *(const PG8_LAS bf16x8*)(lds + PG8_SB(b, h) + boff + n * 2048 + k * 1024); } while (0)
#define PG8_MMA(ai, bj, At, Bt) do { __builtin_amdgcn_s_setprio(1); _Pragma("unroll") for (int m = 0; m < 4; ++m) _Pragma("unroll") for (int n = 0; n < 2; ++n) _Pragma("unroll") for (int k = 0; k < 2; ++k) \
    acc[ai][bj][m][n] = __builtin_amdgcn_mfma_f32_16x16x32_bf16(Bt[n][k], At[m][k], acc[ai][bj][m][n], 0, 0, 0); __builtin_amdgcn_s_setprio(0); } while (0)
#define PG8_WAIT_V(n) asm volatile("s_waitcnt vmcnt(" #n ")" ::: "memory")
#define PG8_WAIT_L(n) asm volatile("s_waitcnt lgkmcnt(" #n ")" ::: "memory")
#define PG8_BAR __builtin_amdgcn_s_barrier()
#define PG8_SCHED __builtin_amdgcn_sched_barrier(0)
  Unit cur, nxt; int ui = 0;
  if (!S.next(0, cur)) return;
  f32x4 acc[2][2][4][2];
#pragma unroll
  for (int a = 0; a < 2; ++a)
#pragma unroll
    for (int b = 0; b < 2; ++b)
#pragma unroll
      for (int m = 0; m < 4; ++m)
#pragma unroll
        for (int n = 0; n < 2; ++n) acc[a][b][m][n] = (f32x4){0.f, 0.f, 0.f, 0.f};
  bf16x8 At[4][2], B0[2][2], B1[2][2];
  const char* cA = (const char*)g.A + (size_t)cur.pm * tstep; const char* cB = (const char*)g.Bt + (size_t)cur.pn * tstep;
  PG8_STAGE(PG8_SB(0, 0), cB, voffB); PG8_STAGE(PG8_SA(0, 0), cA, voffA); PG8_STAGE(PG8_SB(0, 1), cB + hstep, voffB); PG8_STAGE(PG8_SA(0, 1), cA + hstep, voffA);
  if (wr == 1) PG8_BAR;
  PG8_WAIT_V(4); PG8_BAR;
  PG8_STAGE(PG8_SB(1, 0), cB + kstep, voffB); PG8_STAGE(PG8_SA(1, 0), cA + kstep, voffA); PG8_STAGE(PG8_SB(1, 1), cB + hstep + kstep, voffB);
  PG8_WAIT_V(6); PG8_BAR;
  for (;;) {
    const bool has_next = S.next(ui + 1, nxt);
    const char* nA = has_next ? (const char*)g.A + (size_t)nxt.pm * tstep : cA; const char* nB = has_next ? (const char*)g.Bt + (size_t)nxt.pn * tstep : cB;
    for (int t = 0; t < nt; t += 2) {
      const bool last = (t == nt - 2);
      const char* a1 = cA + (size_t)(t + 1) * kstep;
      const char* a2 = last ? nA : cA + (size_t)(t + 2) * kstep; const char* b2 = last ? nB : cB + (size_t)(t + 2) * kstep;
      const char* a3 = a2 + kstep; const char* b3 = b2 + kstep;
      PG8_LDB(B0, 0, 0); PG8_SCHED; PG8_LDA(At, 0, 0); PG8_STAGE(PG8_SA(1, 1), a1 + hstep, voffA);
      PG8_WAIT_L(8); PG8_BAR; PG8_WAIT_L(0); PG8_MMA(0, 0, At, B0); PG8_BAR; PG8_SCHED;
      PG8_LDB(B1, 0, 1); PG8_STAGE(PG8_SB(0, 0), b2, voffB);
      PG8_BAR; PG8_WAIT_L(0); PG8_MMA(0, 1, At, B1); PG8_BAR;
      PG8_LDA(At, 0, 1); PG8_STAGE(PG8_SA(0, 0), a2, voffA);
      PG8_BAR; PG8_WAIT_L(0); PG8_MMA(1, 0, At, B0); PG8_BAR; PG8_SCHED;
      PG8_STAGE(PG8_SB(0, 1), b2 + hstep, voffB);
      PG8_WAIT_V(6); PG8_BAR; PG8_MMA(1, 1, At, B1); PG8_BAR;
      PG8_LDB(B0, 1, 0); PG8_SCHED; PG8_LDA(At, 1, 0); PG8_STAGE(PG8_SA(0, 1), a2 + hstep, voffA);
      PG8_WAIT_L(8); PG8_BAR; PG8_WAIT_L(0); PG8_MMA(0, 0, At, B0); PG8_BAR; PG8_SCHED;
      PG8_LDB(B1, 1, 1); PG8_STAGE(PG8_SB(1, 0), b3, voffB);
      PG8_BAR; PG8_WAIT_L(0); PG8_MMA(0, 1, At, B1); PG8_BAR;
      PG8_LDA(At, 1, 1); PG8_STAGE(PG8_SA(1, 0), a3, voffA);
      PG8_BAR; PG8_WAIT_L(0); PG8_MMA(1, 0, At, B0); PG8_BAR; PG8_SCHED;
      PG8_STAGE(PG8_SB(1, 1), b3 + hstep, voffB);
      PG8_WAIT_V(6); PG8_BAR; PG8_MMA(1, 1, At, B1); PG8_BAR;
    }
    E(acc, cur, wr, wc, fr, fq);
    if (!has_next) break;
#pragma unroll
    for (int a = 0; a < 2; ++a)
#pragma unroll
      for (int b = 0; b < 2; ++b)
#pragma unroll
        for (int m = 0; m < 4; ++m)
#pragma unroll
          for (int n = 0; n < 2; ++n) acc[a][b][m][n] = (f32x4){0.f, 0.f, 0.f, 0.f};
    cur = nxt; cA = nA; cB = nB; ++ui;
  }
  PG8_WAIT_V(0);
  if (wr == 0) PG8_BAR;
  PG8_BAR;
#undef PG8_SA
#undef PG8_SB
#undef PG8_STAGE
#undef PG8_LDA
#undef PG8_LDB
#undef PG8_MMA
#undef PG8_WAIT_V
#undef PG8_WAIT_L
#undef PG8_BAR
#undef PG8_SCHED
}
}

DI void phase_inproj(const Params& p, int l, unsigned char* smem_base) {
  pg8::Gemm g; g.A = (const u16*)(p.ws + OFF_H); g.Bt = (const u16*)(p.ws + OFF_WIN) + (size_t)l * LDZ * LDH; g.M = MTOK; g.N = LDZ; g.K = DM; g.ld = LDH;
  pg8::StaticOrder S; S.init(MTOK, LDZ, gridDim.x, blockIdx.x);
  pg8::EpiBf16 E; E.O = (u16*)(p.ws + OFF_Z); E.ldc = LDZ;
  pg8::gemm_phase(( PG8_LAS unsigned char*)smem_base, g, S, E);
}

template <int NKT>
DI void attn_scores(f32x4 (&S)[NKT], const u16* sKw, const bf16x8 (&qf)[4], int lane) {
#pragma unroll
  for (int kt = 0; kt < NKT; ++kt) {
    S[kt] = f32x4{0.f, 0.f, 0.f, 0.f};
#pragma unroll
    for (int ks = 0; ks < 4; ++ks) {
      const bf16x8 kf = ldfrag(sKw + (kt * 16 + (lane & 15)) * 136 + ks * 32 + (lane >> 4) * 8);
      S[kt] = mfma16(kf, qf[ks], S[kt]);
    }
  }
}
template <int NKT>
DI void attn_pv(f32x4 (&O)[8], const f32x4 (&P)[NKT], const u16* sVTw, int ldv, int lane) {
#pragma unroll
  for (int ct = 0; ct < 8; ++ct) O[ct] = f32x4{0.f, 0.f, 0.f, 0.f};
#pragma unroll
  for (int pp = 0; pp < NKT / 2; ++pp) {
    bf16x8 pf;
#pragma unroll
    for (int j = 0; j < 4; ++j) { pf[j] = (short)f2bf(P[2 * pp][j]); pf[4 + j] = (short)f2bf(P[2 * pp + 1][j]); }
#pragma unroll
    for (int ct = 0; ct < 8; ++ct) {
      const u16* vp = sVTw + (ct * 16 + (lane & 15)) * ldv + (2 * pp) * 16 + (lane >> 4) * 4;
      const s16x4 lo = *(const s16x4*)vp;
      const s16x4 hi = *(const s16x4*)(vp + 16);
      const bf16x8 vf = __builtin_shufflevector(lo, hi, 0, 1, 2, 3, 4, 5, 6, 7);
      O[ct] = mfma16(vf, pf, O[ct]);
    }
  }
}

typedef short v4i16_t __attribute__((ext_vector_type(4)));
template <int NKT>
DI void attn_pv_tr(f32x4 (&O)[8], const f32x4 (&P)[NKT], const u16* sVw, int ldv, int lane) {
#pragma unroll
  for (int ct = 0; ct < 8; ++ct) O[ct] = f32x4{0.f, 0.f, 0.f, 0.f};
#pragma unroll
  for (int pp = 0; pp < NKT / 2; ++pp) {
    bf16x8 pf;
#pragma unroll
    for (int j = 0; j < 4; ++j) { pf[j] = (short)f2bf(P[2 * pp][j]); pf[4 + j] = (short)f2bf(P[2 * pp + 1][j]); }
    const u16* vrow = sVw + ((2 * pp) * 16 + (lane >> 4) * 4 + ((lane & 15) >> 2)) * ldv + (lane & 3) * 4;
#pragma unroll
    for (int ct = 0; ct < 8; ++ct) {
      const s16x4 lo = __builtin_bit_cast(s16x4, __builtin_amdgcn_ds_read_tr16_b64_v4i16((__attribute__((address_space(3))) v4i16_t*)(vrow + ct * 16)));
      const s16x4 hi = __builtin_bit_cast(s16x4, __builtin_amdgcn_ds_read_tr16_b64_v4i16((__attribute__((address_space(3))) v4i16_t*)(vrow + 16 * ldv + ct * 16)));
      const bf16x8 vf = __builtin_shufflevector(lo, hi, 0, 1, 2, 3, 4, 5, 6, 7);
      O[ct] = mfma16(vf, pf, O[ct]);
    }
  }
}

DI void unit_attnA(const Params& p, const Bucket& bk, const SB& sb, int u, unsigned char* smem, int dry) {
  u16* Z = (u16*)(p.ws + OFF_Z);
  float* LSE = (float*)(p.ws + OFF_LSE);
  u16* sK = (u16*)smem;
  float* sBias = (float*)(smem + 59904);
  const int tid = TIDX(), lane = tid & 63, w = tid >> 6;
  const int L = sb.L, B = sb.B, nblk = L / 64;
  const int blk = u % nblk; int t = u / nblk; const int b = t % B; const int gh = t / B; const int g = gh >> 2, h = gh & 3;
  const int d = (g == 0) ? 1 : (g == 1 ? 4 : 16);
  const int M = L / d, nbr = M / 64, r = blk / nbr, m0 = (blk % nbr) * 64;
  const size_t rowbase = (size_t)b * L;
  const int qcol = C_QA + g * 512 + h * 128, kcol = C_KA + g * 512 + h * 128, vcol = C_VA + g * 512 + h * 128;
  __syncthreads();
  if (tid < 129) sBias[tid] = ((const float*)(p.ws + OFF_DFT + 98304))[(g * 4 + h) * 129 + tid];
  for (int id = tid; id < 208 * 16; id += 256) {
    const int kk = id >> 4, ch = id & 15;
    const int km = m0 - 64 + kk;
    const int kmc = min(max(km, 0), M - 1);
    u32x4 v = *(const u32x4*)(Z + (rowbase + (size_t)kmc * d + r) * LDZ + kcol + ch * 8);
    if (km != kmc) v = u32x4{0u, 0u, 0u, 0u};
    *(u32x4*)(sK + kk * 136 + ch * 8) = v;
  }
  bf16x8 qf[4];
  const size_t qrow = rowbase + (size_t)(m0 + w * 16 + (lane & 15)) * d + r;
#pragma unroll
  for (int ks = 0; ks < 4; ++ks) qf[ks] = ldfrag(Z + qrow * LDZ + qcol + ks * 32 + (lane >> 4) * 8);
  u32x4 vreg[13];
#pragma unroll
  for (int i = 0; i < 13; ++i) {
    const int id = tid + i * 256, kk = id >> 4, ch = id & 15;
    const int km = m0 - 64 + kk;
    const int kmc = min(max(km, 0), M - 1);
    vreg[i] = *(const u32x4*)(Z + (rowbase + (size_t)kmc * d + r) * LDZ + vcol + ch * 8);
    if (km != kmc) vreg[i] = u32x4{0u, 0u, 0u, 0u};
  }
  __syncthreads();
  f32x4 S[10];
  attn_scores<10>(S, sK + (w * 16) * 136, qf, lane);
  float mx = -3.0e38f;
#pragma unroll
  for (int kt = 0; kt < 10; ++kt)
#pragma unroll
    for (int i = 0; i < 4; ++i) {
      const int kkr = kt * 16 + (lane >> 4) * 4 + i;
      const int rel = kkr - 64 - (lane & 15);
      const int km = m0 - 64 + w * 16 + kkr;
      const bool ok = (rel >= -64) && (rel <= 64) && (km >= 0) && (km < M);
      const int bi = min(max(rel + 64, 0), 128);
      const float s = ok ? S[kt][i] * QSCALE + sBias[bi] : -1e30f;
      S[kt][i] = s;
      mx = fmaxf(mx, s);
    }
  mx = fmaxf(mx, __shfl_xor(mx, 16));
  mx = fmaxf(mx, __shfl_xor(mx, 32));
  float sum = 0.f;
#pragma unroll
  for (int kt = 0; kt < 10; ++kt)
#pragma unroll
    for (int i = 0; i < 4; ++i) { const float e = __expf(S[kt][i] - mx); S[kt][i] = e; sum += e; }
  sum += __shfl_xor(sum, 16);
  sum += __shfl_xor(sum, 32);
  __syncthreads();
  u16* sV = sK;
#pragma unroll
  for (int i = 0; i < 13; ++i) {
    const int id = tid + i * 256, kk = id >> 4, ch = id & 15;
    *(u32x4*)(sV + kk * 144 + ch * 8) = vreg[i];
  }
  __syncthreads();
  f32x4 O[8];
  attn_pv_tr<10>(O, S, sV + (w * 16) * 144, 144, lane);
  const float inv = 1.f / sum;
  if (!dry) {
#pragma unroll
    for (int ct = 0; ct < 8; ++ct) {
      u32x2 o; o.x = pack2(O[ct][0] * inv, O[ct][1] * inv); o.y = pack2(O[ct][2] * inv, O[ct][3] * inv);
      *(u32x2*)(Z + qrow * LDZ + qcol + ct * 16 + (lane >> 4) * 4) = o;
    }
  }
  if ((lane >> 4) == 0) LSE[qrow * 12 + g * 4 + h] = mx + __logf(sum);
}

DI void unit_attnD(const Params& p, const SB& sb, int l, int u, unsigned char* smem) {
  const u16* Z = (const u16*)(p.ws + OFF_Z);
  u16* GATED = (u16*)(p.ws + OFF_GATED);
  u16* sK = (u16*)smem;
  const int tid = TIDX(), lane = tid & 63, w = tid >> 6;
  const int h = u & 3, rb = u >> 2;
  const int row0 = rb * 64;
  const int b = row0 / sb.L;
  const size_t kvbase = ((size_t)(l * 6 + sb.memb + b) * 4 + h) * 256 * 128;
  const u16* KVK = (const u16*)(p.ws + OFF_KVK) + kvbase;
  const u16* KVV = (const u16*)(p.ws + OFF_KVV) + kvbase;
  __syncthreads();
  for (int id = tid; id < 256 * 16; id += 256) {
    const int m = id >> 4, ch = id & 15;
    *(u32x4*)(sK + m * 136 + ch * 8) = *(const u32x4*)(KVK + m * 128 + ch * 8);
  }
  bf16x8 qf[4];
  const size_t qrow = (size_t)row0 + w * 16 + (lane & 15);
#pragma unroll
  for (int ks = 0; ks < 4; ++ks) qf[ks] = ldfrag(Z + qrow * LDZ + C_QD + h * 128 + ks * 32 + (lane >> 4) * 8);
  __syncthreads();
  f32x4 S[16];
  attn_scores<16>(S, sK, qf, lane);
  float mx = -3.0e38f;
#pragma unroll
  for (int kt = 0; kt < 16; ++kt)
#pragma unroll
    for (int i = 0; i < 4; ++i) { S[kt][i] *= QSCALE; mx = fmaxf(mx, S[kt][i]); }
  mx = fmaxf(mx, __shfl_xor(mx, 16));
  mx = fmaxf(mx, __shfl_xor(mx, 32));
  float sum = 0.f;
#pragma unroll
  for (int kt = 0; kt < 16; ++kt)
#pragma unroll
    for (int i = 0; i < 4; ++i) { const float e = __expf(S[kt][i] - mx); S[kt][i] = e; sum += e; }
  sum += __shfl_xor(sum, 16);
  sum += __shfl_xor(sum, 32);
  __syncthreads();
  u16* sVT = sK;
  for (int id = tid; id < 128 * 32; id += 256) {
    const int c = id >> 5, ch = id & 31;
    *(u32x4*)(sVT + c * 264 + ch * 8) = *(const u32x4*)(KVV + c * 256 + ch * 8);
  }
  __syncthreads();
  f32x4 O[8];
  attn_pv<16>(O, S, sVT, 264, lane);
  const float inv = 1.f / sum;
#pragma unroll
  for (int ct = 0; ct < 8; ++ct) {
    const int c = h * 128 + ct * 16 + (lane >> 4) * 4;
    u32x2 o;
    o.x = pack2(O[ct][0] * inv, O[ct][1] * inv);
    o.y = pack2(O[ct][2] * inv, O[ct][3] * inv);
    *(u32x2*)(GATED + qrow * LDG + 1536 + c) = o;
  }
}

DI void conv8(const u16* __restrict__ Zb, int L, int pos, int col, const float* __restrict__ cw, int cwcol, float (&o)[8]) {
  float a[8];
#pragma unroll
  for (int e = 0; e < 8; ++e) a[e] = 0.f;
  u32x4 zv[5];
#pragma unroll
  for (int j = 0; j < 5; ++j) {
    const int pp = min(max(pos + j - 2, 0), L - 1);
    zv[j] = *(const u32x4*)(Zb + (size_t)pp * LDZ + col);
  }
#pragma unroll
  for (int j = 0; j < 5; ++j) {
    const int pp = pos + j - 2;
    const float ok = (pp >= 0 && pp < L) ? 1.f : 0.f;
    float f[8];
    unpack8(zv[j], f);
    const float4 w0 = *(const float4*)(cw + j * 1024 + cwcol);
    const float4 w1 = *(const float4*)(cw + j * 1024 + cwcol + 4);
    a[0] += f[0] * (w0.x * ok); a[1] += f[1] * (w0.y * ok); a[2] += f[2] * (w0.z * ok); a[3] += f[3] * (w0.w * ok);
    a[4] += f[4] * (w1.x * ok); a[5] += f[5] * (w1.y * ok); a[6] += f[6] * (w1.z * ok); a[7] += f[7] * (w1.w * ok);
  }
#pragma unroll
  for (int e = 0; e < 8; ++e) o[e] = siluf_(a[e]);
}
DI void gate_stats(const Params& p, const u16* Zrow0  , int l, int h, int dir, int lane, int& t, float& bcum, float& uu, float& g) {
  t = dir ? 63 - lane : lane;
  const u16* zr = Zrow0 + (size_t)t * LDZ + C_GC + dir * 8 + h;
  const float ip = bf2f(zr[0]) + p.gate_bias[l * 16 + dir * 8 + h];
  const float fp = bf2f(zr[4]) + p.gate_bias[l * 16 + dir * 8 + 4 + h];
  float v = logsigf_(fp);
#pragma unroll
  for (int o = 1; o < 64; o <<= 1) { const float n = __shfl_up(v, o); if (lane >= o) v += n; }
  bcum = v;
  g = __shfl(v, 63);
  uu = ip - v;
}

DI void unit_mlstm_local(const Params& p, const SB& sb, int l, int u, unsigned char* smem) {
  const u16* Z = (const u16*)(p.ws + OFF_Z);
  u16* CS = (u16*)(p.ws + OFF_CS);
  float* NS = (float*)(p.ws + OFF_NS);
  float* SCG = (float*)(p.ws + OFF_SC);
  float* SCMA = SCG + 2048;
  u16* sKW = (u16*)smem;
  u16* sVT = sKW + 2 * 128 * 72;
  float* sWa = (float*)(sVT + 128 * 72);
  const int tid = TIDX(), lane = tid & 63, w = tid >> 6;
  const int N = sb.L / 64;
  const int h = u & 3; int cidx = u >> 2; const int n = cidx % N, b = cidx / N;
  const size_t row0 = (size_t)b * sb.L + (size_t)n * 64;
  __syncthreads();
  if (w < 2) {
    int t; float bc, uu, g;
    gate_stats(p, Z + row0 * LDZ, l, h, w, lane, t, bc, uu, g);
    const float a = g + uu;
    const float ma = wmaxr(a);
    sWa[w * 64 + t] = __expf(a - ma);
    if (lane == 0) { const int seq = (b * 4 + h) * 2 + w; SCG[seq * N + n] = g; SCMA[seq * N + n] = ma; }
  }
  __syncthreads();
  const u16* Zb = Z + (size_t)b * sb.L * LDZ;
  const float* cw = p.conv_qk + (size_t)l * 5 * 1024;
#pragma unroll 1
  for (int i = 0; i < 4; ++i) {
    const int id = tid + i * 256, t = id & 63, ch = id >> 6;
    float km[8];
    conv8(Zb, sb.L, n * 64 + t, C_KC + h * 128 + ch * 8, cw, 512 + h * 128 + ch * 8, km);
    const float wf = sWa[t], wb = sWa[64 + t];
    const u32x4 vv = *(const u32x4*)(Z + (row0 + t) * LDZ + C_VC + h * 128 + ch * 8);
    const unsigned vw[4] = {vv.x, vv.y, vv.z, vv.w};
#pragma unroll
    for (int e = 0; e < 8; ++e) {
      sKW[(ch * 8 + e) * 72 + t] = f2bf(km[e] * wf);
      sKW[(128 + ch * 8 + e) * 72 + t] = f2bf(km[e] * wb);
      sVT[(ch * 8 + e) * 72 + t] = (u16)((e & 1) ? (vw[e >> 1] >> 16) : (vw[e >> 1] & 0xffff));
    }
  }
  __syncthreads();
  {
    const int dir = tid >> 7, dd = tid & 127;
    float s = 0.f;
    const u16* kp = sKW + (dir * 128 + dd) * 72;
#pragma unroll 8
    for (int t = 0; t < 64; ++t) s += bf2f(kp[t]);
    const int seq = (b * 4 + h) * 2 + dir;
    NS[((size_t)seq * N + n) * 128 + dd] = s;
  }
#pragma unroll 1
  for (int dir = 0; dir < 2; ++dir) {
    f32x4 acc[2][8];
#pragma unroll
    for (int a = 0; a < 2; ++a)
#pragma unroll
      for (int c = 0; c < 8; ++c) acc[a][c] = f32x4{0.f, 0.f, 0.f, 0.f};
#pragma unroll
    for (int ks = 0; ks < 2; ++ks) {
      bf16x8 af[2], bfv[8];
#pragma unroll
      for (int mt = 0; mt < 2; ++mt) af[mt] = ldfrag(sKW + (dir * 128 + w * 32 + mt * 16 + (lane & 15)) * 72 + ks * 32 + (lane >> 4) * 8);
#pragma unroll
      for (int nt = 0; nt < 8; ++nt) bfv[nt] = ldfrag(sVT + (nt * 16 + (lane & 15)) * 72 + ks * 32 + (lane >> 4) * 8);
#pragma unroll
      for (int mt = 0; mt < 2; ++mt)
#pragma unroll
        for (int nt = 0; nt < 8; ++nt) acc[mt][nt] = mfma16(af[mt], bfv[nt], acc[mt][nt]);
    }
    const int seq = (b * 4 + h) * 2 + dir;
    u16* cs = CS + ((size_t)seq * N + n) * 16384;
#pragma unroll
    for (int mt = 0; mt < 2; ++mt)
#pragma unroll
      for (int nt = 0; nt < 8; ++nt) {
        const int e = nt * 16 + (lane & 15), dd = w * 32 + mt * 16 + (lane >> 4) * 4;
        u32x2 o; o.x = pack2(acc[mt][nt][0], acc[mt][nt][1]); o.y = pack2(acc[mt][nt][2], acc[mt][nt][3]);
        *(u32x2*)(cs + e * 128 + dd) = o;
      }
  }
}

DI void unit_mlstm_scan(const Params& p, const SB& sb, int u, unsigned char* smem, int dry) {
  u16* CS = (u16*)(p.ws + OFF_CS);
  float* NS = (float*)(p.ws + OFF_NS);
  const float* SCG = (const float*)(p.ws + OFF_SC);
  const float* SCMA = SCG + 2048;
  float* SCMP = (float*)(p.ws + OFF_SC) + 4096;
  float* sOld = (float*)smem;
  float* sNew = sOld + 256;
  const int tid = TIDX();
  const int N = sb.L / 64;
  const int seq = u >> 5, slab = u & 31, dir = seq & 1;
  __syncthreads();
  if (tid < N) { sOld[tid] = SCG[seq * N + tid]; sNew[tid] = SCMA[seq * N + tid]; }
  __syncthreads();
  if (tid == 0) {
    float m = 0.f;
    for (int i = 0; i < N; ++i) {
      const int n = dir ? N - 1 - i : i;
      const float g = sOld[n], ma = sNew[n];
      const float mn = fmaxf(g + m, ma);
      sOld[n] = __expf(g + m - mn);
      sNew[n] = __expf(ma - mn);
      if (slab == 0) SCMP[seq * N + n] = m;
      m = mn;
    }
  }
  __syncthreads();
  unsigned* cs = (unsigned*)(CS + (size_t)seq * N * 16384) + slab * 256 + tid;
  float c0 = 0.f, c1 = 0.f;
  for (int i0 = 0; i0 < N; i0 += 32) {
    unsigned v[32];
#pragma unroll
    for (int j = 0; j < 32; ++j) { const int n = dir ? N - 1 - (i0 + j) : i0 + j; v[j] = cs[(size_t)n * 8192]; }
#pragma unroll
    for (int j = 0; j < 32; ++j) {
      const int n = dir ? N - 1 - (i0 + j) : i0 + j;
      if (!dry) cs[(size_t)n * 8192] = pack2(c0, c1);
      const float so = sOld[n], sn = sNew[n];
      c0 = so * c0 + sn * bflo(v[j]);
      c1 = so * c1 + sn * bfhi(v[j]);
    }
  }
  if (slab == 0 && tid < 128) {
    float* ns = NS + (size_t)seq * N * 128 + tid;
    float a = 0.f;
    for (int i0 = 0; i0 < N; i0 += 16) {
      float v[16];
#pragma unroll
      for (int j = 0; j < 16; ++j) { const int n = dir ? N - 1 - (i0 + j) : i0 + j; v[j] = ns[(size_t)n * 128]; }
#pragma unroll
      for (int j = 0; j < 16; ++j) {
        const int n = dir ? N - 1 - (i0 + j) : i0 + j;
        if (!dry) ns[(size_t)n * 128] = a;
        a = sOld[n] * a + sNew[n] * v[j];
      }
    }
  }
}

DI void unit_mlstm_out(const Params& p, const SB& sb, int l, int u, unsigned char* smem) {
  const u16* Z = (const u16*)(p.ws + OFF_Z);
  const u16* CS = (const u16*)(p.ws + OFF_CS);
  const float* NS = (const float*)(p.ws + OFF_NS);
  const float* SCMP = (const float*)(p.ws + OFF_SC) + 4096;
  u16* GATED = (u16*)(p.ws + OFF_GATED);
  u16* sQ = (u16*)smem;
  u16* sK = sQ + 64 * 136;
  u16* sV = sK + 64 * 136;
  u16* sSQ = sV + 64 * 144;
  float* sU = (float*)(sSQ + 64 * 72);
  float* sMx = sU + 128;
  float* sB = sMx + 128;
  float* sNp = sB + 128;
  float* sMp = sNp + 256;
  const int tid = TIDX(), lane = tid & 63, w = tid >> 6;
  const int N = sb.L / 64;
  const int h = u & 3; int cidx = u >> 2; const int n = cidx % N, b = cidx / N;
  const size_t row0 = (size_t)b * sb.L + (size_t)n * 64;
  const int seq0 = (b * 4 + h) * 2;
  __syncthreads();
  if (w < 2) {
    int t; float bc, uu, g;
    gate_stats(p, Z + row0 * LDZ, l, h, w, lane, t, bc, uu, g);
    float pm = uu;
#pragma unroll
    for (int o = 1; o < 64; o <<= 1) { const float nn = __shfl_up(pm, o); if (lane >= o) pm = fmaxf(pm, nn); }
    const float mp = SCMP[(seq0 + w) * N + n];
    sU[w * 64 + t] = uu;
    sMx[w * 64 + t] = fmaxf(mp, pm);
    sB[w * 64 + t] = bc;
    if (lane == 0) sMp[w] = mp;
  }
  {
    const int dir = tid >> 7, dd = tid & 127;
    sNp[tid] = NS[((size_t)(seq0 + dir) * N + n) * 128 + dd];
  }
  const u16* Zb = Z + (size_t)b * sb.L * LDZ;
  const float* cw = p.conv_qk + (size_t)l * 5 * 1024;
#pragma unroll 1
  for (int i = 0; i < 4; ++i) {
    const int id = tid + i * 256, ch = id & 15, t = id >> 4;
    float qm[8], km[8];
    const u32x4 vv = *(const u32x4*)(Z + (row0 + t) * LDZ + C_VC + h * 128 + ch * 8);
    conv8(Zb, sb.L, n * 64 + t, C_QC + h * 128 + ch * 8, cw, h * 128 + ch * 8, qm);
    conv8(Zb, sb.L, n * 64 + t, C_KC + h * 128 + ch * 8, cw, 512 + h * 128 + ch * 8, km);
    u32x4 qo, ko;
    qo.x = pack2(qm[0] * QSCALE, qm[1] * QSCALE); qo.y = pack2(qm[2] * QSCALE, qm[3] * QSCALE);
    qo.z = pack2(qm[4] * QSCALE, qm[5] * QSCALE); qo.w = pack2(qm[6] * QSCALE, qm[7] * QSCALE);
    ko.x = pack2(km[0], km[1]); ko.y = pack2(km[2], km[3]); ko.z = pack2(km[4], km[5]); ko.w = pack2(km[6], km[7]);
    *(u32x4*)(sQ + t * 136 + ch * 8) = qo;
    *(u32x4*)(sK + t * 136 + ch * 8) = ko;
    *(u32x4*)(sV + t * 144 + ch * 8) = vv;
  }
  __syncthreads();
  const int tq = w * 16 + (lane & 15);
  f32x4 S[4];
  {
    bf16x8 qf[4];
#pragma unroll
    for (int ks = 0; ks < 4; ++ks) qf[ks] = ldfrag(sQ + tq * 136 + ks * 32 + (lane >> 4) * 8);
#pragma unroll
    for (int mt = 0; mt < 4; ++mt) {
      S[mt] = f32x4{0.f, 0.f, 0.f, 0.f};
#pragma unroll
      for (int ks = 0; ks < 4; ++ks) {
        const bf16x8 kf = ldfrag(sK + (mt * 16 + (lane & 15)) * 136 + ks * 32 + (lane >> 4) * 8);
        S[mt] = mfma16(kf, qf[ks], S[mt]);
      }
    }
  }
  f32x4 hc[8];
#pragma unroll
  for (int mt = 0; mt < 8; ++mt) hc[mt] = f32x4{0.f, 0.f, 0.f, 0.f};
#pragma unroll 1
  for (int dir = 0; dir < 2; ++dir) {
    const float Mx = sMx[dir * 64 + tq];
    const float mp = sMp[dir];
    const float winter = __expf(mp - Mx);
    const float em = __expf(-(sB[dir * 64 + tq] + Mx));
    float dq = 0.f;
    {
      const u16* qp = sQ + tq * 136 + (lane >> 4) * 32;
      const float* np_ = sNp + dir * 128 + (lane >> 4) * 32;
#pragma unroll 8
      for (int j = 0; j < 32; ++j) dq += bf2f(qp[j]) * np_[j];
    }
    dq += __shfl_xor(dq, 16);
    dq += __shfl_xor(dq, 32);
    float dsum = 0.f;
    __syncthreads();
#pragma unroll
    for (int mt = 0; mt < 4; ++mt) {
      float v[4];
#pragma unroll
      for (int i = 0; i < 4; ++i) {
        const int s = mt * 16 + (lane >> 4) * 4 + i;
        const bool ok = dir ? (s >= tq) : (s <= tq);
        const float wi = ok ? __expf(fminf(sU[dir * 64 + s] - Mx, 0.f)) : 0.f;
        v[i] = S[mt][i] * wi;
        dsum += v[i];
      }
      u32x2 o; o.x = pack2(v[0], v[1]); o.y = pack2(v[2], v[3]);
      *(u32x2*)(sSQ + tq * 72 + mt * 16 + (lane >> 4) * 4) = o;
    }
    dsum += __shfl_xor(dsum, 16);
    dsum += __shfl_xor(dsum, 32);
    const float den = winter * dq + dsum;
    const float rden = 1.f / fmaxf(fabsf(den), em);
    __syncthreads();
    const u16* cs = CS + ((size_t)(seq0 + dir) * N + n) * 16384;
    f32x4 acc[8];
#pragma unroll
    for (int mt = 0; mt < 8; ++mt) acc[mt] = f32x4{0.f, 0.f, 0.f, 0.f};
#pragma unroll
    for (int ks = 0; ks < 4; ++ks) {
      const bf16x8 qf = ldfrag(sQ + tq * 136 + ks * 32 + (lane >> 4) * 8);
#pragma unroll
      for (int mt = 0; mt < 8; ++mt) {
        const bf16x8 cf = ldfrag(cs + (mt * 16 + (lane & 15)) * 128 + ks * 32 + (lane >> 4) * 8);
        acc[mt] = mfma16(cf, qf, acc[mt]);
      }
    }
#pragma unroll
    for (int mt = 0; mt < 8; ++mt)
#pragma unroll
      for (int i = 0; i < 4; ++i) acc[mt][i] *= winter;
#pragma unroll
    for (int ks = 0; ks < 2; ++ks) {
      const bf16x8 pf = ldfrag(sSQ + tq * 72 + ks * 32 + (lane >> 4) * 8);
#pragma unroll
      for (int mt = 0; mt < 8; ++mt) {
        const u16* vp = sV + (ks * 32 + (lane >> 4) * 8 + ((lane & 15) >> 2)) * 144 + mt * 16 + (lane & 3) * 4;
        const s16x4 vlo = __builtin_bit_cast(s16x4, __builtin_amdgcn_ds_read_tr16_b64_v4i16((__attribute__((address_space(3))) v4i16_t*)vp));
        const s16x4 vhi = __builtin_bit_cast(s16x4, __builtin_amdgcn_ds_read_tr16_b64_v4i16((__attribute__((address_space(3))) v4i16_t*)(vp + 4 * 144)));
        const bf16x8 vf = __builtin_shufflevector(vlo, vhi, 0, 1, 2, 3, 4, 5, 6, 7);
        acc[mt] = mfma16(vf, pf, acc[mt]);
      }
    }
#pragma unroll
    for (int mt = 0; mt < 8; ++mt)
#pragma unroll
      for (int i = 0; i < 4; ++i) hc[mt][i] += acc[mt][i] * rden;
  }
  const size_t row = row0 + tq;
  float s1 = 0.f;
#pragma unroll
  for (int mt = 0; mt < 8; ++mt) {
    const u32x2 oc = *(const u32x2*)(Z + row * LDZ + C_OC + h * 128 + mt * 16 + (lane >> 4) * 4);
    hc[mt][0] *= sigmoidf_(bflo(oc.x)); hc[mt][1] *= sigmoidf_(bfhi(oc.x));
    hc[mt][2] *= sigmoidf_(bflo(oc.y)); hc[mt][3] *= sigmoidf_(bfhi(oc.y));
    s1 += hc[mt][0] + hc[mt][1] + hc[mt][2] + hc[mt][3];
  }
  s1 += __shfl_xor(s1, 16);
  s1 += __shfl_xor(s1, 32);
  const float mu = s1 * (1.f / 128.f);
  float s2 = 0.f;
#pragma unroll
  for (int mt = 0; mt < 8; ++mt)
#pragma unroll
    for (int i = 0; i < 4; ++i) { const float dlt = hc[mt][i] - mu; s2 += dlt * dlt; }
  s2 += __shfl_xor(s2, 16);
  s2 += __shfl_xor(s2, 32);
  const float rs = rsqrtf(s2 * (1.f / 128.f) + EPSV);
#pragma unroll
  for (int mt = 0; mt < 8; ++mt) {
    const int c = h * 128 + mt * 16 + (lane >> 4) * 4;
    const float4 hg = *(const float4*)(p.head_gain + l * 512 + c);
    const u32x2 gp = *(const u32x2*)(Z + row * LDZ + C_GP + 2 * 512 + c);
    u32x2 o;
    o.x = pack2((hc[mt][0] - mu) * rs * hg.x * siluf_(bflo(gp.x)), (hc[mt][1] - mu) * rs * hg.y * siluf_(bfhi(gp.x)));
    o.y = pack2((hc[mt][2] - mu) * rs * hg.z * siluf_(bflo(gp.y)), (hc[mt][3] - mu) * rs * hg.w * siluf_(bfhi(gp.y)));
    *(u32x2*)(GATED + row * LDG + 1024 + c) = o;
  }
}

template <int N1>
DI void unit_fft1(const Params& p, const SB& sb, int u, unsigned char* smem) {
  constexpr int N2 = N1;
  constexpr int LDU = N1 + 8;
  constexpr int MTW = N1 / 64;
  const u16* Z = (const u16*)(p.ws + OFF_Z);
  const u16* DFT = (const u16*)(p.ws + OFF_DFT);
  const u16* DC128 = DFT, *DS128 = DFT + 16384;
  const u16* DC1 = (N1 == 128) ? DFT : DFT + 32768;
  const u16* DS1 = (N1 == 128) ? DFT + 16384 : DFT + 36864;
  u16* HR = (u16*)(p.ws + OFF_OUT);
  u16* HI = HR + (size_t)MTOK * 512;
  u16* sX = (u16*)smem;
  u16* sUT = sX + 128 * 136;
  u16* sVT = sUT + 64 * 136;
  const int tid = TIDX(), lane = tid & 63, w = tid >> 6;
  const int qh = u & 1, g4 = (u >> 1) & 3; int t2 = u >> 3; const int n2 = t2 % N2, b = t2 / N2;
  const int L = sb.L;
  __syncthreads();
  for (int id = tid; id < N1 * 16; id += 256) {
    const int n1 = id >> 4, ch = id & 15;
    *(u32x4*)(sX + n1 * 136 + ch * 8) = *(const u32x4*)(Z + ((size_t)b * L + (size_t)N2 * n1 + n2) * LDZ + C_XB + g4 * 128 + ch * 8);
  }
  __syncthreads();
  {
    f32x4 au[MTW][4], av[MTW][4];
#pragma unroll
    for (int a = 0; a < MTW; ++a)
#pragma unroll
      for (int c = 0; c < 4; ++c) { au[a][c] = f32x4{0.f, 0.f, 0.f, 0.f}; av[a][c] = f32x4{0.f, 0.f, 0.f, 0.f}; }
#pragma unroll
    for (int ks = 0; ks < 4; ++ks) {
      bf16x8 xf[MTW], cf[4], sf[4];
#pragma unroll
      for (int mt = 0; mt < MTW; ++mt) xf[mt] = ldfrag(sX + ((w * MTW + mt) * 16 + (lane & 15)) * 136 + ks * 32 + (lane >> 4) * 8);
#pragma unroll
      for (int nt = 0; nt < 4; ++nt) {
        const int q = qh * 64 + nt * 16 + (lane & 15);
        cf[nt] = ldfrag(DC128 + q * 128 + ks * 32 + (lane >> 4) * 8);
        sf[nt] = ldfrag(DS128 + q * 128 + ks * 32 + (lane >> 4) * 8);
      }
#pragma unroll
      for (int mt = 0; mt < MTW; ++mt)
#pragma unroll
        for (int nt = 0; nt < 4; ++nt) { au[mt][nt] = mfma16(xf[mt], cf[nt], au[mt][nt]); av[mt][nt] = mfma16(xf[mt], sf[nt], av[mt][nt]); }
    }
#pragma unroll
    for (int mt = 0; mt < MTW; ++mt)
#pragma unroll
      for (int nt = 0; nt < 4; ++nt) {
        const int ql = nt * 16 + (lane & 15), n1 = (w * MTW + mt) * 16 + (lane >> 4) * 4;
        u32x2 o; o.x = pack2(au[mt][nt][0], au[mt][nt][1]); o.y = pack2(au[mt][nt][2], au[mt][nt][3]);
        *(u32x2*)(sUT + ql * LDU + n1) = o;
        o.x = pack2(av[mt][nt][0], av[mt][nt][1]); o.y = pack2(av[mt][nt][2], av[mt][nt][3]);
        *(u32x2*)(sVT + ql * LDU + n1) = o;
      }
  }
  __syncthreads();
  f32x4 gr[MTW][4], gi[MTW][4];
#pragma unroll
  for (int a = 0; a < MTW; ++a)
#pragma unroll
    for (int c = 0; c < 4; ++c) { gr[a][c] = f32x4{0.f, 0.f, 0.f, 0.f}; gi[a][c] = f32x4{0.f, 0.f, 0.f, 0.f}; }
#pragma unroll
  for (int ks = 0; ks < N1 / 32; ++ks) {
    bf16x8 uf[4], vf[4];
#pragma unroll
    for (int nt = 0; nt < 4; ++nt) {
      uf[nt] = ldfrag(sUT + (nt * 16 + (lane & 15)) * LDU + ks * 32 + (lane >> 4) * 8);
      vf[nt] = ldfrag(sVT + (nt * 16 + (lane & 15)) * LDU + ks * 32 + (lane >> 4) * 8);
    }
#pragma unroll
    for (int mt = 0; mt < MTW; ++mt) {
      const int k1 = (w * MTW + mt) * 16 + (lane & 15);
      const bf16x8 cf = ldfrag(DC1 + k1 * N1 + ks * 32 + (lane >> 4) * 8);
      const bf16x8 sf = ldfrag(DS1 + k1 * N1 + ks * 32 + (lane >> 4) * 8);
      const bf16x8 sn = negfrag(sf);
#pragma unroll
      for (int nt = 0; nt < 4; ++nt) {
        gr[mt][nt] = mfma16(uf[nt], cf, gr[mt][nt]);
        gr[mt][nt] = mfma16(vf[nt], sn, gr[mt][nt]);
        gi[mt][nt] = mfma16(uf[nt], sf, gi[mt][nt]);
        gi[mt][nt] = mfma16(vf[nt], cf, gi[mt][nt]);
      }
    }
  }
  const float sc = rsqrtf((float)(N1 * 128));
#pragma unroll
  for (int mt = 0; mt < MTW; ++mt) {
    const int k1 = (w * MTW + mt) * 16 + (lane & 15);
    const float ang = 2.f * (float)((n2 * k1) % L) / (float)L;
    const float cph = cospif(ang) * sc, sph = sinpif(ang) * sc;
    const size_t base = (((size_t)b * N1 + k1) * N2 + n2) * 512 + g4 * 128 + qh * 64;
#pragma unroll
    for (int nt = 0; nt < 4; ++nt) {
      float hr[4], hi[4];
#pragma unroll
      for (int i = 0; i < 4; ++i) { hr[i] = gr[mt][nt][i] * cph - gi[mt][nt][i] * sph; hi[i] = gr[mt][nt][i] * sph + gi[mt][nt][i] * cph; }
      u32x2 o; o.x = pack2(hr[0], hr[1]); o.y = pack2(hr[2], hr[3]);
      *(u32x2*)(HR + base + nt * 16 + (lane >> 4) * 4) = o;
      o.x = pack2(hi[0], hi[1]); o.y = pack2(hi[2], hi[3]);
      *(u32x2*)(HI + base + nt * 16 + (lane >> 4) * 4) = o;
    }
  }
}

template <int N2>
DI void unit_fft2(const Params& p, const SB& sb, int u, unsigned char* smem) {
  constexpr int N1 = N2;
  constexpr int LDH = N2 + 8;
  constexpr int MTW = N2 / 64;
  const u16* Z = (const u16*)(p.ws + OFF_Z);
  const u16* DFT = (const u16*)(p.ws + OFF_DFT);
  const u16* DC2 = (N2 == 128) ? DFT : DFT + 32768;
  const u16* DS2 = (N2 == 128) ? DFT + 16384 : DFT + 36864;
  const u16* HR = (const u16*)(p.ws + OFF_OUT);
  const u16* HI = HR + (size_t)MTOK * 512;
  u16* GATED = (u16*)(p.ws + OFF_GATED);
  u16* sHr = (u16*)smem;
  u16* sHi = sHr + 128 * 136;
  const int tid = TIDX(), lane = tid & 63, w = tid >> 6;
  const int g4 = u & 3; int t2 = u >> 2; const int k1 = t2 % N1, b = t2 / N1;
  const int L = sb.L;
  __syncthreads();
  for (int id = tid; id < N2 * 16; id += 256) {
    const int n2 = id % N2, ch = id / N2;
    const size_t src = (((size_t)b * N1 + k1) * N2 + n2) * 512 + g4 * 128 + ch * 8;
    const u32x4 a = *(const u32x4*)(HR + src);
    const u32x4 c = *(const u32x4*)(HI + src);
    const unsigned aw[4] = {a.x, a.y, a.z, a.w}, cw[4] = {c.x, c.y, c.z, c.w};
#pragma unroll
    for (int e = 0; e < 8; ++e) {
      sHr[(ch * 8 + e) * LDH + n2] = (u16)((e & 1) ? (aw[e >> 1] >> 16) : (aw[e >> 1] & 0xffff));
      sHi[(ch * 8 + e) * LDH + n2] = (u16)((e & 1) ? (cw[e >> 1] >> 16) : (cw[e >> 1] & 0xffff));
    }
  }
  __syncthreads();
  f32x4 acc[MTW][8];
#pragma unroll
  for (int a = 0; a < MTW; ++a)
#pragma unroll
    for (int c = 0; c < 8; ++c) acc[a][c] = f32x4{0.f, 0.f, 0.f, 0.f};
#pragma unroll
  for (int ks = 0; ks < N2 / 32; ++ks) {
    bf16x8 cf[MTW], sn[MTW];
#pragma unroll
    for (int mt = 0; mt < MTW; ++mt) {
      const int k2 = (w * MTW + mt) * 16 + (lane & 15);
      cf[mt] = ldfrag(DC2 + k2 * N2 + ks * 32 + (lane >> 4) * 8);
      sn[mt] = negfrag(ldfrag(DS2 + k2 * N2 + ks * 32 + (lane >> 4) * 8));
    }
#pragma unroll
    for (int nt = 0; nt < 8; ++nt) {
      const bf16x8 hr = ldfrag(sHr + (nt * 16 + (lane & 15)) * LDH + ks * 32 + (lane >> 4) * 8);
      const bf16x8 hi = ldfrag(sHi + (nt * 16 + (lane & 15)) * LDH + ks * 32 + (lane >> 4) * 8);
#pragma unroll
      for (int mt = 0; mt < MTW; ++mt) { acc[mt][nt] = mfma16(hr, cf[mt], acc[mt][nt]); acc[mt][nt] = mfma16(hi, sn[mt], acc[mt][nt]); }
    }
  }
  const float sc = rsqrtf((float)N2);
#pragma unroll
  for (int mt = 0; mt < MTW; ++mt) {
    const int k2 = (w * MTW + mt) * 16 + (lane & 15);
    const size_t row = (size_t)b * L + (size_t)k1 + (size_t)N1 * k2;
#pragma unroll
    for (int nt = 0; nt < 8; ++nt) {
      const int c = g4 * 128 + nt * 16 + (lane >> 4) * 4;
      const u32x2 gp = *(const u32x2*)(Z + row * LDZ + C_GP + 512 + c);
      u32x2 o;
      o.x = pack2(acc[mt][nt][0] * sc * siluf_(bflo(gp.x)), acc[mt][nt][1] * sc * siluf_(bfhi(gp.x)));
      o.y = pack2(acc[mt][nt][2] * sc * siluf_(bflo(gp.y)), acc[mt][nt][3] * sc * siluf_(bfhi(gp.y)));
      *(u32x2*)(GATED + row * LDG + 512 + c) = o;
    }
  }
}

DI void unit_attn_combine(const Params& p, int u) {
  const u16* Z = (const u16*)(p.ws + OFF_Z);
  const float* LSE = (const float*)(p.ws + OFF_LSE);
  u16* GATED = (u16*)(p.ws + OFF_GATED);
  const int tid = TIDX(), lane = tid & 63, w = tid >> 6;
#pragma unroll 1
  for (int rr = 0; rr < 4; ++rr) {
    const size_t row = (size_t)u * 16 + w * 4 + rr;
    const int c = lane * 8, h = c >> 7;
    const float l0 = LSE[row * 12 + h], l1 = LSE[row * 12 + 4 + h], l2 = LSE[row * 12 + 8 + h];
    const float mx = fmaxf(l0, fmaxf(l1, l2));
    const float e0 = __expf(l0 - mx), e1 = __expf(l1 - mx), e2 = __expf(l2 - mx);
    const float inv = 1.f / (e0 + e1 + e2);
    float o0[8], o1[8], o2[8], gp[8];
    unpack8(*(const u32x4*)(Z + row * LDZ + C_QA + c), o0);
    unpack8(*(const u32x4*)(Z + row * LDZ + C_QA + 512 + c), o1);
    unpack8(*(const u32x4*)(Z + row * LDZ + C_QA + 1024 + c), o2);
    unpack8(*(const u32x4*)(Z + row * LDZ + C_GP + c), gp);
    float y[8];
#pragma unroll
    for (int e = 0; e < 8; ++e) y[e] = (e0 * o0[e] + e1 * o1[e] + e2 * o2[e]) * inv * siluf_(gp[e]);
    u32x4 o; o.x = pack2(y[0], y[1]); o.y = pack2(y[2], y[3]); o.z = pack2(y[4], y[5]); o.w = pack2(y[6], y[7]);
    *(u32x4*)(GATED + row * LDG + c) = o;
    float dv[8], dg[8];
    unpack8(*(const u32x4*)(GATED + row * LDG + 1536 + c), dv);
    unpack8(*(const u32x4*)(Z + row * LDZ + C_GP + 3 * 512 + c), dg);
    u32x4 od; od.x = pack2(dv[0] * siluf_(dg[0]), dv[1] * siluf_(dg[1])); od.y = pack2(dv[2] * siluf_(dg[2]), dv[3] * siluf_(dg[3]));
    od.z = pack2(dv[4] * siluf_(dg[4]), dv[5] * siluf_(dg[5])); od.w = pack2(dv[6] * siluf_(dg[6]), dv[7] * siluf_(dg[7]));
    *(u32x4*)(GATED + row * LDG + 1536 + c) = od;
  }
}

DI void phase_branchproj(const Params& p, int l, unsigned char* smem_) {
  const u16* Z = (const u16*)(p.ws + OFF_Z);
  const u16* GATED = (const u16*)(p.ws + OFF_GATED);
  const u16* WbT = (const u16*)(p.ws + OFF_WB) + (size_t)l * DM * LDG;
  u16* MERGED = (u16*)(p.ws + OFF_H);
  u16* smem = (u16*)smem_;
  const int tid = TIDX(), lane = tid & 63, w = tid >> 6, wm = w >> 1, wn = w & 1;
  constexpr bool PIPE = false;
  u16* sA = smem;
  u16* sB = smem + 2 * 8192;
  const int lr = tid >> 3, lc = (tid & 7) * 8;
  const int wsw = ((tid & 7) ^ ((lr >> 1) & 7)) * 8;
  const int rg = (lane & 15) >> 1, rq = lane >> 4;
  const int rs0 = (((rg >> 2) * 4) + (rq ^ (rg & 3))) * 8;
  const int rs1 = ((((rg >> 2) ^ 1) * 4) + (rq ^ (rg & 3))) * 8;
  for (int u = VB(); u < 8 * 128; u += VG()) {
    const int nt0 = u / 128, mt0 = u % 128;
    const u16* A = GATED + (size_t)mt0 * 128 * LDG;
    const u16* Bt = WbT + (size_t)nt0 * 128 * LDG;
    const int lda = LDG, ldb = LDG;
    f32x4 mer[4][4], acc[4][4];
    zero_acc(mer);
    zero_acc(acc);
    u32x4 r0a[4], r0b[4];
    G_LOAD(r0a, r0b, 0)
    __syncthreads();
    G_WRITE(r0a, r0b, 0)
    __syncthreads();
#pragma unroll 1
    for (int kt = 0; kt < 32; ++kt) {
      const int buf = kt & 1, g = kt >> 3;
      if (kt + 1 < 32) { G_LOAD(r0a, r0b, (kt + 1) * 64) }
      G_COMPUTE(buf)
      if (kt + 1 < 32) { G_WRITE(r0a, r0b, buf ^ 1) }
      __syncthreads();
      if ((kt & 7) == 7) {
#pragma unroll
        for (int mt = 0; mt < 4; ++mt)
#pragma unroll
          for (int nt = 0; nt < 4; ++nt) {
            const int row = mt0 * 128 + wm * 64 + mt * 16 + (lane & 15);
            const int col = nt0 * 128 + wn * 64 + nt * 16 + (lane >> 4) * 4;
            const u32x2 mg = *(const u32x2*)(Z + (size_t)row * LDZ + C_MG + g * 1024 + col);
            mer[mt][nt][0] += sigmoidf_(bflo(mg.x)) * acc[mt][nt][0];
            mer[mt][nt][1] += sigmoidf_(bfhi(mg.x)) * acc[mt][nt][1];
            mer[mt][nt][2] += sigmoidf_(bflo(mg.y)) * acc[mt][nt][2];
            mer[mt][nt][3] += sigmoidf_(bfhi(mg.y)) * acc[mt][nt][3];
            acc[mt][nt] = f32x4{0.f, 0.f, 0.f, 0.f};
          }
      }
    }
#pragma unroll
    for (int mt = 0; mt < 4; ++mt)
#pragma unroll
      for (int nt = 0; nt < 4; ++nt) {
        const int row = mt0 * 128 + wm * 64 + mt * 16 + (lane & 15);
        const int col = nt0 * 128 + wn * 64 + nt * 16 + (lane >> 4) * 4;
        u32x2 o; o.x = pack2(mer[mt][nt][0], mer[mt][nt][1]); o.y = pack2(mer[mt][nt][2], mer[mt][nt][3]);
        *(u32x2*)(MERGED + (size_t)row * LDH + col) = o;
      }
  }
}

DI void phase_outproj(const Params& p, int l, unsigned char* smem_base) {
  pg8::Gemm g; g.A = (const u16*)(p.ws + OFF_H); g.Bt = (const u16*)(p.ws + OFF_WO) + (size_t)l * DM * LDH; g.M = MTOK; g.N = DM; g.K = DM; g.ld = LDH;
  pg8::StaticOrder S; S.init(MTOK, DM, gridDim.x, blockIdx.x);
  pg8::EpiBf16 E; E.O = (u16*)(p.ws + OFF_OUT); E.ldc = DM;
  pg8::gemm_phase((PG8_LAS unsigned char*)smem_base, g, S, E);
}

DI void mix1_unit(const Params& p, const Bucket& bk, const SB& sb, int l, unsigned char* smem, int dry, int u) {
  const int nF = sb.B * sb.N1 * 8;
  const int nC = (MTOK / 64) * 4;
  const int nD = (MTOK / 64) * 4;
  int v = u;
  if (v < nF) { if (!dry || (PROBE_UNITS & 1)) { if (sb.N1 == 128) unit_fft1<128>(p, sb, v, smem); else unit_fft1<64>(p, sb, v, smem); } return; }
  v -= nF;
  if (v < nC) { if (!dry || (PROBE_UNITS & 2)) unit_mlstm_local(p, sb, l, v, smem); return; }
  v -= nC;
  if (v < nD) { if (!dry || (PROBE_UNITS & 4)) unit_attnD(p, sb, l, v, smem); return; }
  v -= nD;
  if (!dry || (PROBE_UNITS & 8)) unit_attnA(p, bk, sb, v, smem, dry);
}
DI void phase_mix1(const Params& p, const Bucket& bk, const SB& sb, int l, unsigned char* smem, int dry, unsigned* qhead, volatile unsigned* qslot) {
  const int nF = sb.B * sb.N1 * 8;
  const int tot = MTOK * 12 / 64 + nF + 2 * (MTOK / 64) * 4;
  if (qhead == nullptr) {
    for (int u = VB(); u < tot; u += VG()) mix1_unit(p, bk, sb, l, smem, dry, u);
    return;
  }
  const int half = HALF_ID();
  if (threadIdx.x == 0) *qslot = xb_add(qhead, 1u);
  __syncthreads();
  for (;;) {
    const int k = (int)*qslot;
    if (2 * k >= tot) break;
    unsigned nxt = 0u;
    if (threadIdx.x == 0) nxt = xb_add(qhead, 1u);
    const int pos = 2 * k + half;
    const int u = (pos < tot - nF) ? pos + nF : pos - (tot - nF);
    mix1_unit(p, bk, sb, l, smem, dry, u);
    __syncthreads();
    if (threadIdx.x == 0) *qslot = nxt;
    __syncthreads();
  }
}
DI void mix2_unit(const Params& p, const SB& sb, unsigned char* smem, int dry, int u) {
  const int nS = sb.B * 8 * 32, nA = MTOK / 16;
  int v = u;
  if (v < nS) { unit_mlstm_scan(p, sb, v, smem, dry); return; }
  v -= nS;
  if (v < nA) { unit_attn_combine(p, v); return; }
  v -= nA;
  if (sb.N1 == 128) unit_fft2<128>(p, sb, v, smem); else unit_fft2<64>(p, sb, v, smem);
}
DI void phase_mix2(const Params& p, const SB& sb, int l, unsigned char* smem, int dry, unsigned* qhead, volatile unsigned* qslot) {
  const int nF = sb.B * sb.N1 * 4;
  const int nS = sb.B * 8 * 32;
  const int nA = MTOK / 16;
  const int tot = nF + nS + nA;
  if (qhead == nullptr) {
    for (int u = VB(); u < tot; u += VG()) mix2_unit(p, sb, smem, dry, u);
    return;
  }
  const int half = HALF_ID();
  if (threadIdx.x == 0) *qslot = xb_add(qhead, 1u);
  __syncthreads();
  for (;;) {
    const int k = (int)*qslot;
    if (2 * k >= tot) break;
    unsigned nxt = 0u;
    if (threadIdx.x == 0) nxt = xb_add(qhead, 1u);
    const int pos = 2 * k + half;
    const int u = (pos < nS) ? pos : (pos < nS + nF ? pos + nA : pos - nF);
    mix2_unit(p, sb, smem, dry, u);
    __syncthreads();
    if (threadIdx.x == 0) *qslot = nxt;
    __syncthreads();
  }
}
DI void phase_mix3(const Params& p, const SB& sb, int l, unsigned char* smem) {
  const int nC = (MTOK / 64) * 4;
  for (int u = VB(); u < nC; u += VG()) unit_mlstm_out(p, sb, l, u, smem);
}

constexpr int STEPS_PER_SB = 4 * 7 + 1;
constexpr int N_STEPS = 2 + 3 * STEPS_PER_SB;

DI void run_step(const Params& p0, const Bucket& bk, int s, unsigned char* smem_base, int dry, bool coop, volatile unsigned* qslot) {
  Params p = p0;
  asm volatile("" : "+s"(p.ws));
  unsigned char* smem = smem_base + HALF_ID() * SMEM_HALF;
  if (s == 0) { phase_prep0(p, bk, smem); return; }
  int sbi, l, ph;
  if (coop) {
    if (s == 1) { phase_prep1(p, smem); const SB sb0 = get_sb(p, 0); phase_rows(p, sb0, 0, dry); return; }
    const int s2 = s - 2, r = s2 % 28; sbi = s2 / 28;
    if (r == 27) {
      const SB sbx = get_sb(p, sbi); phase_rows(p, sbx, 4, dry);
      if (sbi < 2) { const SB sbn = get_sb(p, sbi + 1); phase_rows(p, sbn, 0, dry); }
      return;
    }
    if (r < 6) { l = 0; ph = r + 1; } else { const int q = r - 6; l = 1 + q / 7; ph = q % 7; }
  } else {
    if (s == 1) { phase_prep1(p, smem); return; }
    const int s2 = s - 2, r = s2 % STEPS_PER_SB; sbi = s2 / STEPS_PER_SB;
    if (r == 28) { const SB sbx = get_sb(p, sbi); phase_rows(p, sbx, 4, dry); return; }
    l = r / 7; ph = r % 7;
  }
  const SB sb = get_sb(p, sbi);
  switch (ph) {
    case 0: phase_rows(p, sb, l, dry); break;
    case 1: phase_inproj(p, l, smem_base); break;
    case 2: phase_mix1(p, bk, sb, l, smem, dry, coop ? (unsigned*)(p.ws + OFF_BAR) + 4096 + (s & 127) : nullptr, qslot); break;
    case 3: phase_mix2(p, sb, l, smem, dry, coop ? (unsigned*)(p.ws + OFF_BAR) + 4096 + (s & 127) : nullptr, qslot); break;
    case 4: phase_mix3(p, sb, l, smem); break;
    case 5: phase_branchproj(p, l, smem); break;
    default: phase_outproj(p, l, smem_base); break;
  }
}

__global__ void __launch_bounds__(512, 2) mega_step(Params p, Bucket bk, int s, int dry) {
  extern __shared__ __attribute__((aligned(16))) unsigned char smem[];
  run_step(p, bk, s, smem, dry, false, nullptr);
}

__global__ void __launch_bounds__(512, 2) mega_coop(Params p, Bucket bk) {
  extern __shared__ __attribute__((aligned(16))) unsigned char smem[];
  __shared__ uint4 xb_words;
  cg::grid_group grid = cg::this_grid();
  if (p.ws == nullptr) grid.sync();
  if (threadIdx.x == 0) xb_words = make_uint4(0u, 0u, 0u, 0u);
  __syncthreads();
  (void)xcd_barrier_post((unsigned*)(p.ws + OFF_BAR), (volatile LAS unsigned*)&xb_words);
  constexpr int N_STEPS_COOP = 2 + 3 * 28;
#pragma unroll 1
  for (int s = 0; s < N_STEPS_COOP; ++s) {
    run_step(p, bk, s, smem, 0, true, (volatile unsigned*)&xb_words + 2);
    if (s + 1 < N_STEPS_COOP) {
      XcdBarrier xb; xb.bar = (unsigned*)(p.ws + OFF_BAR); xb.x = xb_xcc_id(); xb.st = (volatile LAS unsigned*)&xb_words;
      xcd_barrier(xb);
    }
  }
}

static int t5_bucket_host(int rel) {
  const int nb = 16, max_exact = 8;
  int ret = (rel > 0) ? nb : 0;
  int n = rel < 0 ? -rel : rel;
  int nn = n > 1 ? n : 1;
  int large = max_exact + (int)(std::log((double)nn / max_exact) / std::log(1024.0 / max_exact) * (nb - max_exact));
  if (large > nb - 1) large = nb - 1;
  return ret + (n < max_exact ? n : large);
}

extern "C" void kernel_launch(void* const* d_in, const int* in_sizes, int n_in, void* d_out, int out_size, void* d_ws,
                              size_t ws_size, hipStream_t stream) {
  Params p;
  memset(&p, 0, sizeof(p));
  p.x_prompt = (const float*)d_in[0]; p.x_sample = (const float*)d_in[1];
  p.mem_prompt = (const float*)d_in[2]; p.mem_sample = (const float*)d_in[3];
  p.rel_bias = (const float*)d_in[4]; p.norm_pre = (const float*)d_in[5]; p.w_in = (const float*)d_in[6];
  p.conv_qk = (const float*)d_in[7]; p.gate_bias = (const float*)d_in[8]; p.head_gain = (const float*)d_in[9];
  p.mem_norm = (const float*)d_in[10]; p.w_mem_kv = (const float*)d_in[11]; p.w_branch = (const float*)d_in[12];
  p.w_out = (const float*)d_in[13]; p.norm_post = (const float*)d_in[14];
  p.out = (float*)d_out;
  p.ws = (unsigned char*)d_ws;
  Bucket bk;
  memset(&bk, 0, sizeof(bk));
  const int dil[3] = {1, 4, 16};
  for (int g = 0; g < 3; ++g)
    for (int i = 0; i < 129; ++i) bk.b[g][i] = (unsigned char)t5_bucket_host(dil[g] * (i - 64));
  if (ws_size < WS_NEED) fprintf(stderr, "workspace too small: %zu < %zu\n", ws_size, (size_t)WS_NEED);

  static int grid_blocks = 0;
  if (!grid_blocks) {
    int dev = 0, cus = 0, per_cu = 0;
    hipGetDevice(&dev);
    hipDeviceGetAttribute(&cus, hipDeviceAttributeMultiprocessorCount, dev);
    hipFuncSetAttribute((const void*)mega_step, hipFuncAttributeMaxDynamicSharedMemorySize, SMEM_BYTES);
    hipFuncSetAttribute((const void*)mega_coop, hipFuncAttributeMaxDynamicSharedMemorySize, SMEM_BYTES);
    hipOccupancyMaxActiveBlocksPerMultiprocessor(&per_cu, mega_coop, 512, SMEM_BYTES);
    if (per_cu < 1) per_cu = 1;
    if (per_cu > 1) per_cu = 1;
    grid_blocks = cus * per_cu;
  }
#if MK_COOP
  hipMemsetAsync((unsigned char*)d_ws + OFF_BAR, 0, (4096 + 128) * sizeof(unsigned), stream);
  void* args[] = {&p, &bk};
  hipError_t e = hipLaunchCooperativeKernel((void*)mega_coop, dim3(grid_blocks), dim3(512), args, SMEM_BYTES, stream);
  if (e != hipSuccess) fprintf(stderr, "cooperative launch failed: %s (grid %d)\n", hipGetErrorString(e), grid_blocks);
#else
  for (int s = 0; s < N_STEPS; ++s) {
    if (PROBE_REPEAT > 0 && s >= 2 && ((s - 2) % STEPS_PER_SB) != 28 && ((PROBE_REPEAT >> (((s - 2) % STEPS_PER_SB) % 7)) & 1))
      hipLaunchKernelGGL(mega_step, dim3(grid_blocks), dim3(512), SMEM_BYTES, stream, p, bk, s, 1);
    hipLaunchKernelGGL(mega_step, dim3(grid_blocks), dim3(512), SMEM_BYTES, stream, p, bk, s, 0);
  }
#endif
}
```

```cpp
#include <hip/hip_runtime.h>
#include <hip/hip_cooperative_groups.h>
#include <cstdio>
#include <cstring>
#include <cmath>
namespace cg = cooperative_groups;

#ifndef MK_COOP
#define MK_COOP 1
#endif
#ifndef PROBE_UNITS
#define PROBE_UNITS 15
#endif
#ifndef PROBE_REPEAT
#define PROBE_REPEAT 0
#endif

typedef unsigned short u16;
using bf16x8 = __attribute__((ext_vector_type(8))) short;
using s16x4 = __attribute__((ext_vector_type(4))) short;
using f32x4 = __attribute__((ext_vector_type(4))) float;
using u32x4 = __attribute__((ext_vector_type(4))) unsigned;
using u32x2 = __attribute__((ext_vector_type(2))) unsigned;
#define DI __device__ __forceinline__

constexpr int DM = 1024;
constexpr int LDZ = 14080;
constexpr int NORIG = 13840;
constexpr int C_QA = 0, C_KA = 1536, C_VA = 3072, C_XB = 4608, C_QC = 5120, C_KC = 5632, C_VC = 6144, C_OC = 6656,
              C_QD = 7168, C_GP = 7680, C_MG = 9728, C_GC = 13824;
constexpr int LDH = 1088;
constexpr int LDG = 2112;
constexpr int MTOK = 16384;
constexpr float EPSV = 1e-6f;
constexpr float QSCALE = 0.08838834764831845f;
constexpr int SMEM_HALF = 75776;
constexpr int SMEM_BYTES = 2 * SMEM_HALF;

constexpr size_t OFF_WIN = 0;
constexpr size_t OFF_WB = OFF_WIN + (size_t)4 * LDZ * LDH * 2;
constexpr size_t OFF_WO = OFF_WB + (size_t)4 * 1024 * LDG * 2;
constexpr size_t OFF_KVK = OFF_WO + (size_t)4 * 1024 * LDH * 2;
constexpr size_t OFF_KVV = OFF_KVK + 6291456;
constexpr size_t OFF_DFT = OFF_KVV + 6291456;
constexpr size_t OFF_H = OFF_DFT + 131072;
constexpr size_t OFF_GATED = OFF_H + (size_t)16384 * LDH * 2;
constexpr size_t OFF_LSE = OFF_GATED + (size_t)16384 * LDG * 2;
constexpr size_t OFF_OUT = OFF_LSE + 786432;
constexpr size_t OFF_CS = OFF_OUT + 67108864;
constexpr size_t OFF_NS = OFF_CS + 67108864;
constexpr size_t OFF_SC = OFF_NS + 1048576;
constexpr size_t OFF_BAR = OFF_SC + 32768;
constexpr size_t OFF_Z = OFF_SC + 65536;
constexpr size_t OFF_WKV = OFF_Z;
constexpr size_t OFF_HM = OFF_Z + (size_t)4 * 1024 * LDH * 2;
constexpr size_t WS_NEED = OFF_Z + (size_t)16384 * LDZ * 2;

struct Params {
  const float *x_prompt, *x_sample, *mem_prompt, *mem_sample, *rel_bias, *norm_pre, *w_in, *conv_qk, *gate_bias,
      *head_gain, *mem_norm, *w_mem_kv, *w_branch, *w_out, *norm_post;
  float* out;
  unsigned char* ws;
};
struct Bucket { unsigned char b[3][136]; };

DI int TIDX() { int t = threadIdx.x & 255; asm volatile("" : "+v"(t)); return t; }
DI int HALF_ID() { return __builtin_amdgcn_readfirstlane((int)(threadIdx.x >> 8)); }
DI int VB() { return (int)blockIdx.x * 2 + HALF_ID(); }
DI int VG() { return (int)gridDim.x * 2; }
typedef __bf16 bf16x2_t __attribute__((ext_vector_type(2)));
typedef float f32x2_t __attribute__((ext_vector_type(2)));
DI unsigned cvt_pk_bf16_hw(float lo, float hi) { const f32x2_t v = {lo, hi}; return __builtin_bit_cast(unsigned, __builtin_convertvector(v, bf16x2_t)); }
DI u16 f2bf(float x) { return (u16)(cvt_pk_bf16_hw(x, x) & 0xffffu); }
DI float bf2f(u16 h) { return __uint_as_float(((unsigned)h) << 16); }
DI float bflo(unsigned u) { return __uint_as_float(u << 16); }
DI float bfhi(unsigned u) { return __uint_as_float(u & 0xffff0000u); }
DI unsigned pack2(float a, float b) { return cvt_pk_bf16_hw(a, b); }
DI f32x4 mfma16(bf16x8 a, bf16x8 b, f32x4 c) { return __builtin_amdgcn_mfma_f32_16x16x32_bf16(a, b, c, 0, 0, 0); }
DI bf16x8 ldfrag(const u16* p) { return *reinterpret_cast<const bf16x8*>(p); }
DI float wsum(float v) { for (int o = 32; o; o >>= 1) v += __shfl_xor(v, o); return v; }
DI float wmaxr(float v) { for (int o = 32; o; o >>= 1) v = fmaxf(v, __shfl_xor(v, o)); return v; }
DI float sigmoidf_(float x) { return __builtin_amdgcn_rcpf(1.f + __expf(-x)); }
DI float siluf_(float x) { return x * __builtin_amdgcn_rcpf(1.f + __expf(-x)); }
DI float logsigf_(float x) { return fminf(x, 0.f) - log1pf(__expf(-fabsf(x))); }
DI void unpack8(u32x4 v, float (&f)[8]) {
  f[0] = bflo(v.x); f[1] = bfhi(v.x); f[2] = bflo(v.y); f[3] = bfhi(v.y);
  f[4] = bflo(v.z); f[5] = bfhi(v.z); f[6] = bflo(v.w); f[7] = bfhi(v.w);
}
DI bf16x8 negfrag(bf16x8 a) {
  bf16x8 r;
#pragma unroll
  for (int j = 0; j < 8; ++j) r[j] = (short)(a[j] ^ (short)0x8000);
  return r;
}


#define XB_TMO      128
#define XB_XCNT(j)  (256  + 64 * (j))
#define XB_XSUB(j)  (1280 + 64 * (j))
#define XB_XGEN(j)  (2304 + 64 * (j))
#define XB_TOP      3328
#define XB_TOPGEN   3392
#define XCD_BAR_WORDS 3456
#define XB_SPIN_CAP (1u << 22)
#define LAS __attribute__((address_space(3)))
DI unsigned xb_ld(unsigned* p) { return __hip_atomic_load(p, __ATOMIC_RELAXED, __HIP_MEMORY_SCOPE_AGENT); }
DI unsigned xb_add(unsigned* p, unsigned v) { return __hip_atomic_fetch_add(p, v, __ATOMIC_RELAXED, __HIP_MEMORY_SCOPE_AGENT); }
DI unsigned xb_xcc_id() { return (unsigned)__builtin_amdgcn_s_getreg((3 << 11) | 20) & 0xFu; }
#define XB_SPIN(cond, bar) do { unsigned _sp = 0; while (cond) { __builtin_amdgcn_s_sleep(1); \
    if ((++_sp & 255u) == 0u) { if (xb_ld(&(bar)[XB_TMO])) break; if (_sp > XB_SPIN_CAP) { atomicAdd(&(bar)[XB_TMO], 1u); break; } } } } while (0)
struct XcdBarrier { unsigned* bar; unsigned x; volatile LAS unsigned* st; };
DI XcdBarrier xcd_barrier_post(unsigned* bar, volatile LAS unsigned* st) {
  XcdBarrier b; b.bar = bar; b.x = xb_xcc_id(); b.st = st;
  if (threadIdx.x == 0) (void)xb_add(&bar[XB_XCNT(b.x)], 1u);
  return b;
}
DI void xcd_barrier_complete(unsigned* bar, unsigned x, unsigned& nloc, unsigned& nx) {
  const unsigned G = gridDim.x * gridDim.y * gridDim.z;
  unsigned sum, cnt, mine, sp = 0u;
  for (;;) {
    sum = 0u; cnt = 0u; mine = 0u;
#pragma unroll
    for (unsigned j = 0; j < 16; ++j) { const unsigned c = xb_ld(&bar[XB_XCNT(j)]); sum += c; cnt += (c > 0u) ? 1u : 0u; mine = (j == x) ? c : mine; }
    if (sum == G) break;
    __builtin_amdgcn_s_sleep(1);
    if ((++sp & 255u) == 0u) { if (xb_ld(&bar[XB_TMO])) break; if (sp > XB_SPIN_CAP) { atomicAdd(&bar[XB_TMO], 1u); break; } }
  }
  nloc = mine > 0u ? mine : 1u; nx = cnt > 0u ? cnt : 1u;
}
DI void xcd_barrier(const XcdBarrier& b) {
  asm volatile("s_waitcnt vmcnt(0)" ::: "memory");
  __syncthreads();
  if (threadIdx.x == 0) {
    unsigned* bar = b.bar;
    __builtin_amdgcn_s_waitcnt(0);
    unsigned nloc = b.st[0], nx = b.st[1];
    if (nloc == 0u) { xcd_barrier_complete(bar, b.x, nloc, nx); b.st[0] = nloc; b.st[1] = nx; }
    const unsigned old = xb_add(&bar[XB_XSUB(b.x)], 1u);
    const unsigned gen = old / nloc;
    if (old + 1u == (gen + 1u) * nloc) {
      __builtin_amdgcn_fence(__ATOMIC_RELEASE, "agent");
      asm volatile("s_waitcnt vmcnt(0)" ::: "memory");
      const unsigned og = xb_add(&bar[XB_TOP], 1u);
      const unsigned tg = og / nx;
      if (og + 1u == (tg + 1u) * nx) xb_add(&bar[XB_TOPGEN], 1u);
      else XB_SPIN(xb_ld(&bar[XB_TOPGEN]) == tg, bar);
      __builtin_amdgcn_fence(__ATOMIC_ACQUIRE, "agent");
      xb_add(&bar[XB_XGEN(b.x)], 1u);
      asm volatile("s_waitcnt vmcnt(0)" ::: "memory");
    } else {
      XB_SPIN(xb_ld(&bar[XB_XGEN(b.x)]) == gen, bar);
      __builtin_amdgcn_fence(__ATOMIC_ACQUIRE, "agent");
      asm volatile("s_waitcnt vmcnt(0)" ::: "memory");
    }
  }
  __syncthreads();
}

struct SB {
  const float* xin; float* xout; int B, L, memb, N1;
};
DI SB get_sb(const Params& p, int sb) {
  SB s;
  if (sb < 2) { s.xin = p.x_sample + (size_t)sb * MTOK * DM; s.xout = p.out + (size_t)(MTOK + sb * MTOK) * DM; s.B = 1; s.L = 16384; s.memb = 4 + sb; s.N1 = 128; }
  else { s.xin = p.x_prompt; s.xout = p.out; s.B = 4; s.L = 4096; s.memb = 0; s.N1 = 64; }
  return s;
}

#define G_LOAD(RA, RB, K0) _Pragma("unroll") for (int i = 0; i < 4; ++i) { \
    RA[i] = *(const u32x4*)(A + (size_t)(lr + 32 * i) * lda + (K0) + lc); RB[i] = *(const u32x4*)(Bt + (size_t)(lr + 32 * i) * ldb + (K0) + lc); }
#define G_WRITE(RA, RB, BUF) _Pragma("unroll") for (int i = 0; i < 4; ++i) { \
    *(u32x4*)(sA + (BUF) * 8192 + (lr + 32 * i) * 64 + wsw) = RA[i]; *(u32x4*)(sB + (BUF) * 8192 + (lr + 32 * i) * 64 + wsw) = RB[i]; }
#define G_COMPUTE(BUF) { \
    const u16* a0 = sA + (BUF) * 8192 + (wm * 64 + (lane & 15)) * 64; \
    const u16* b0 = sB + (BUF) * 8192 + (wn * 64 + (lane & 15)) * 64; \
    if (PIPE) { \
      bf16x8 a[2][4], b[2][4]; \
      _Pragma("unroll") for (int t = 0; t < 4; ++t) { a[0][t] = ldfrag(a0 + t * 1024 + rs0); b[0][t] = ldfrag(b0 + t * 1024 + rs0); } \
      _Pragma("unroll") for (int t = 0; t < 4; ++t) { a[1][t] = ldfrag(a0 + t * 1024 + rs1); b[1][t] = ldfrag(b0 + t * 1024 + rs1); } \
      __builtin_amdgcn_sched_barrier(0); \
      _Pragma("unroll") for (int ks = 0; ks < 2; ++ks) \
        _Pragma("unroll") for (int mt = 0; mt < 4; ++mt) _Pragma("unroll") for (int nt = 0; nt < 4; ++nt) acc[mt][nt] = mfma16(b[ks][nt], a[ks][mt], acc[mt][nt]); \
      __builtin_amdgcn_sched_barrier(0); \
    } else { \
      _Pragma("unroll") for (int ks = 0; ks < 2; ++ks) { \
        bf16x8 a[4], b[4]; \
        _Pragma("unroll") for (int t = 0; t < 4; ++t) { a[t] = ldfrag(a0 + t * 1024 + (ks ? rs1 : rs0)); b[t] = ldfrag(b0 + t * 1024 + (ks ? rs1 : rs0)); } \
        _Pragma("unroll") for (int mt = 0; mt < 4; ++mt) _Pragma("unroll") for (int nt = 0; nt < 4; ++nt) acc[mt][nt] = mfma16(b[nt], a[mt], acc[mt][nt]); } } }
template <bool DEEP, bool PIPE>
DI void gemm_acc(f32x4 (&acc)[4][4], const u16* __restrict__ A, int lda, const u16* __restrict__ Bt, int ldb, int nk, u16* smem) {
  const int tid = TIDX(), lane = tid & 63, w = tid >> 6, wm = w >> 1, wn = w & 1;
  u16* sA = smem;
  u16* sB = smem + 2 * 8192;
  const int lr = tid >> 3, lc = (tid & 7) * 8;
  const int wsw = ((tid & 7) ^ ((lr >> 1) & 7)) * 8;
  const int rg = (lane & 15) >> 1, rq = lane >> 4;
  const int rs0 = (((rg >> 2) * 4) + (rq ^ (rg & 3))) * 8;
  const int rs1 = ((((rg >> 2) ^ 1) * 4) + (rq ^ (rg & 3))) * 8;
  u32x4 r0a[4], r0b[4];
  G_LOAD(r0a, r0b, 0)
  if (DEEP) {
    u32x4 r1a[4], r1b[4];
    G_LOAD(r1a, r1b, 64)
    __syncthreads();
    G_WRITE(r0a, r0b, 0)
    __syncthreads();
    if (2 < nk) { G_LOAD(r0a, r0b, 128) }
#pragma unroll 1
    for (int kt = 0; kt < nk; kt += 2) {
      G_COMPUTE(0)
      if (kt + 1 < nk) { G_WRITE(r1a, r1b, 1) }
      if (kt + 3 < nk) { G_LOAD(r1a, r1b, (kt + 3) * 64) }
      __syncthreads();
      if (kt + 1 >= nk) break;
      G_COMPUTE(1)
      if (kt + 2 < nk) { G_WRITE(r0a, r0b, 0) }
      if (kt + 4 < nk) { G_LOAD(r0a, r0b, (kt + 4) * 64) }
      __syncthreads();
    }
  } else {
    __syncthreads();
    G_WRITE(r0a, r0b, 0)
    __syncthreads();
#pragma unroll 1
    for (int kt = 0; kt < nk; ++kt) {
      const int buf = kt & 1;
      if (kt + 1 < nk) { G_LOAD(r0a, r0b, (kt + 1) * 64) }
      G_COMPUTE(buf)
      if (kt + 1 < nk) { G_WRITE(r0a, r0b, buf ^ 1) }
      __syncthreads();
    }
  }
}

#define G_READ(F_A, F_B, BUF, RS) { \
    const u16* a0 = sA + (BUF) * 8192 + (wm * 64 + (lane & 15)) * 64 + (RS); \
    const u16* b0 = sB + (BUF) * 8192 + (wn * 64 + (lane & 15)) * 64 + (RS); \
    _Pragma("unroll") for (int t = 0; t < 4; ++t) { F_A[t] = ldfrag(a0 + t * 1024); F_B[t] = ldfrag(b0 + t * 1024); } }
#define G_MMA(F_A, F_B) { \
    _Pragma("unroll") for (int mt = 0; mt < 4; ++mt) _Pragma("unroll") for (int nt = 0; nt < 4; ++nt) acc[mt][nt] = mfma16(F_B[nt], F_A[mt], acc[mt][nt]); }
DI void gemm_acc_sp(f32x4 (&acc)[4][4], const u16* __restrict__ A, int lda, const u16* __restrict__ Bt, int ldb, int nk, u16* smem) {
  const int tid = TIDX(), lane = tid & 63, w = tid >> 6, wm = w >> 1, wn = w & 1;
  u16* sA = smem;
  u16* sB = smem + 2 * 8192;
  const int lr = tid >> 3, lc = (tid & 7) * 8;
  const int wsw = ((tid & 7) ^ ((lr >> 1) & 7)) * 8;
  const int rg = (lane & 15) >> 1, rq = lane >> 4;
  const int rs0 = (((rg >> 2) * 4) + (rq ^ (rg & 3))) * 8;
  const int rs1 = ((((rg >> 2) ^ 1) * 4) + (rq ^ (rg & 3))) * 8;
  u32x4 r0a[4], r0b[4];
  bf16x8 fa0[4], fb0[4], fa1[4], fb1[4];
  G_LOAD(r0a, r0b, 0)
  __syncthreads();
  G_WRITE(r0a, r0b, 0)
  __syncthreads();
  if (1 < nk) { G_LOAD(r0a, r0b, 64) }
  G_READ(fa0, fb0, 0, rs0)
#pragma unroll 1
  for (int kt = 0; kt < nk; ++kt) {
    const int buf = kt & 1;
    G_READ(fa1, fb1, buf, rs1)
    __builtin_amdgcn_sched_barrier(0);
    G_MMA(fa0, fb0)
    __builtin_amdgcn_sched_barrier(0);
    if (kt + 1 < nk) { G_WRITE(r0a, r0b, buf ^ 1) }
    if (kt + 2 < nk) { G_LOAD(r0a, r0b, (kt + 2) * 64) }
    __syncthreads();
    if (kt + 1 < nk) { G_READ(fa0, fb0, buf ^ 1, rs0) }
    __builtin_amdgcn_sched_barrier(0);
    G_MMA(fa1, fb1)
    __builtin_amdgcn_sched_barrier(0);
  }
}
DI void zero_acc(f32x4 (&acc)[4][4]) {
#pragma unroll
  for (int a = 0; a < 4; ++a)
#pragma unroll
    for (int b = 0; b < 4; ++b) acc[a][b] = f32x4{0.f, 0.f, 0.f, 0.f};
}

DI int win_orig_col(int n) { return n < 7168 ? n : (n < 13824 ? n + 16 : (n < 13840 ? n - 13824 + 7168 : -1)); }

template <bool WINMAP>
DI void transpose_tile(const float* __restrict__ src, size_t src_ld, u16* __restrict__ dst, size_t dst_ld, int r0, int c0, float* sT) {
  const int tid = TIDX();
  __syncthreads();
#pragma unroll 4
  for (int i = 0; i < 16; ++i) {
    const int r = i * 4 + (tid >> 6), c = tid & 63;
    int sc = c0 + c;
    if (WINMAP) sc = win_orig_col(sc);
    sT[r * 65 + c] = (sc >= 0) ? src[(size_t)(r0 + r) * src_ld + sc] : 0.f;
  }
  __syncthreads();
#pragma unroll 4
  for (int i = 0; i < 16; ++i) {
    const int c = i * 4 + (tid >> 6), r = tid & 63;
    dst[(size_t)(c0 + c) * dst_ld + r0 + r] = f2bf(sT[r * 65 + c]);
  }
}

DI void phase_prep0(const Params& p, const Bucket& bk, unsigned char* smem) {
  float* sT = (float*)smem;
  u16* WinT = (u16*)(p.ws + OFF_WIN);
  u16* WbT = (u16*)(p.ws + OFF_WB);
  u16* WoT = (u16*)(p.ws + OFF_WO);
  u16* WkvT = (u16*)(p.ws + OFF_WKV);
  u16* HM = (u16*)(p.ws + OFF_HM);
  u16* DFT = (u16*)(p.ws + OFF_DFT);
  constexpr int U_WIN = 4 * 220 * 16, U_WB = 4 * 4 * 8 * 16, U_WO = 4 * 16 * 16, U_WKV = 4 * 16 * 16, U_HM = 1536, U_DFT = 160, U_BT = 8;
  constexpr int TOT = U_WIN + U_WB + U_WO + U_WKV + U_HM + U_DFT + U_BT;
  const int tid = TIDX(), lane = tid & 63, w = tid >> 6;
  for (int u = VB(); u < TOT; u += VG()) {
    int v = u;
    if (v < U_WIN) {
      const int l = v / (220 * 16), r = v % (220 * 16), nt = r / 16, kt = r % 16;
      transpose_tile<true>(p.w_in + (size_t)l * DM * NORIG, NORIG, WinT + (size_t)l * LDZ * LDH, LDH, kt * 64, nt * 64, sT);
      continue;
    }
    v -= U_WIN;
    if (v < U_WB) {
      const int l = v / 512, r = v % 512, g = r / 128, r2 = r % 128, ct = r2 / 16, dt = r2 % 16;
      transpose_tile<false>(p.w_branch + ((size_t)(l * 4 + g) * 512) * DM, DM, WbT + (size_t)l * DM * LDG + g * 512, LDG, ct * 64, dt * 64, sT);
      continue;
    }
    v -= U_WB;
    if (v < U_WO) {
      const int l = v / 256, r = v % 256, kt = r / 16, nt = r % 16;
      transpose_tile<false>(p.w_out + (size_t)l * DM * DM, DM, WoT + (size_t)l * DM * LDH, LDH, kt * 64, nt * 64, sT);
      continue;
    }
    v -= U_WO;
    if (v < U_WKV) {
      const int l = v / 256, r = v % 256, kt = r / 16, nt = r % 16;
      transpose_tile<false>(p.w_mem_kv + (size_t)l * DM * DM, DM, WkvT + (size_t)l * DM * LDH, LDH, kt * 64, nt * 64, sT);
      continue;
    }
    v -= U_WKV;
    if (v < U_HM) {
      const int row = v;
      if (w == 0) {
        const float* src = (row < 1024) ? p.mem_prompt + (size_t)row * DM : p.mem_sample + (size_t)(row - 1024) * DM;
        float4 xv[4];
        float ss = 0.f;
#pragma unroll
        for (int i = 0; i < 4; ++i) { xv[i] = *(const float4*)(src + (i * 64 + lane) * 4); ss += xv[i].x * xv[i].x + xv[i].y * xv[i].y + xv[i].z * xv[i].z + xv[i].w * xv[i].w; }
        ss = wsum(ss);
        const float rstd = rsqrtf(ss * (1.f / DM) + EPSV);
        for (int l = 0; l < 4; ++l) {
#pragma unroll
          for (int i = 0; i < 4; ++i) {
            const float4 g = *(const float4*)(p.mem_norm + l * DM + (i * 64 + lane) * 4);
            u32x2 o; o.x = pack2(xv[i].x * rstd * g.x, xv[i].y * rstd * g.y); o.y = pack2(xv[i].z * rstd * g.z, xv[i].w * rstd * g.w);
            *(u32x2*)(HM + ((size_t)l * 1536 + row) * LDH + (i * 64 + lane) * 4) = o;
          }
        }
      }
      continue;
    }
    v -= U_HM;
    if (v >= U_DFT) {
      const int e = (v - U_DFT) * 256 + tid;
      if (e < 3 * 4 * 129) {
        const int gh = e / 129, i = e % 129, g = gh >> 2;
        ((float*)(p.ws + OFF_DFT + 98304))[e] = p.rel_bias[(int)bk.b[g][i] * 12 + gh];
      }
      continue;
    }
    {
      const int e = v * 256 + tid;
      if (e < 40960) {
        int N, idx, isS;
        if (e < 32768) { N = 128; isS = e >= 16384; idx = e & 16383; }
        else { N = 64; isS = (e - 32768) >= 4096; idx = (e - 32768) & 4095; }
        const int i = idx / N, j = idx % N;
        const float a = 2.f * (float)((i * j) % N) / (float)N;
        DFT[e] = f2bf(isS ? sinpif(a) : cospif(a));
      }
    }
  }
}

DI void phase_prep1(const Params& p, unsigned char* smem) {
  const u16* WkvT = (const u16*)(p.ws + OFF_WKV);
  const u16* HM = (const u16*)(p.ws + OFF_HM);
  u16* KVK = (u16*)(p.ws + OFF_KVK);
  u16* KVV = (u16*)(p.ws + OFF_KVV);
  const int tid = TIDX(), lane = tid & 63, w = tid >> 6, wm = w >> 1, wn = w & 1;
  for (int u = VB(); u < 4 * 12 * 8; u += VG()) {
    const int l = u / 96, r = u % 96, mt0 = r / 8, nt0 = r % 8;
    f32x4 acc[4][4];
    zero_acc(acc);
    gemm_acc<false, true>(acc, HM + ((size_t)l * 1536 + mt0 * 128) * LDH, LDH, WkvT + ((size_t)l * DM + nt0 * 128) * LDH, LDH, 16, (u16*)smem);
#pragma unroll
    for (int mt = 0; mt < 4; ++mt)
#pragma unroll
      for (int nt = 0; nt < 4; ++nt)
#pragma unroll
        for (int i = 0; i < 4; ++i) {
          const int row = mt0 * 128 + wm * 64 + mt * 16 + (lane & 15);
          const int col = nt0 * 128 + wn * 64 + nt * 16 + (lane >> 4) * 4 + i;
          const int b = row >> 8, m = row & 255;
          const int sel = col >> 9, h = (col >> 7) & 3, c = col & 127;
          const u16 val = f2bf(acc[mt][nt][i]);
          const size_t base = ((size_t)(l * 6 + b) * 4 + h) * 256 * 128;
          if (sel == 0) KVK[base + m * 128 + c] = val;
          else KVV[base + c * 256 + m] = val;
        }
  }
}

DI void phase_rows(const Params& p, const SB& sb, int l, int dry) {
  const u16* OUTB = (const u16*)(p.ws + OFF_OUT);
  u16* H = (u16*)(p.ws + OFF_H);
  const int tid = TIDX(), lane = tid & 63, w = tid >> 6;
  for (int row = VB() * 4 + w; row < MTOK; row += VG() * 4) {
    float4 xv[4];
    if (l == 0) {
#pragma unroll
      for (int i = 0; i < 4; ++i) xv[i] = *(const float4*)(sb.xin + (size_t)row * DM + (i * 64 + lane) * 4);
    } else {
      const float* xp = (l == 1 ? sb.xin : sb.xout) + (size_t)row * DM;
      float4 ov[4];
      float ss = 0.f;
#pragma unroll
      for (int i = 0; i < 4; ++i) { const u32x2 ob = *(const u32x2*)(OUTB + (size_t)row * DM + (i * 64 + lane) * 4);
        ov[i].x = bflo(ob.x); ov[i].y = bfhi(ob.x); ov[i].z = bflo(ob.y); ov[i].w = bfhi(ob.y);
        ss += ov[i].x * ov[i].x + ov[i].y * ov[i].y + ov[i].z * ov[i].z + ov[i].w * ov[i].w; }
      ss = wsum(ss);
      const float rstd = rsqrtf(ss * (1.f / DM) + EPSV);
#pragma unroll
      for (int i = 0; i < 4; ++i) {
        const float4 g = *(const float4*)(p.norm_post + (l - 1) * DM + (i * 64 + lane) * 4);
        const float4 xo = *(const float4*)(xp + (i * 64 + lane) * 4);
        xv[i].x = xo.x + ov[i].x * rstd * g.x; xv[i].y = xo.y + ov[i].y * rstd * g.y;
        xv[i].z = xo.z + ov[i].z * rstd * g.z; xv[i].w = xo.w + ov[i].w * rstd * g.w;
        if (!dry) *(float4*)(sb.xout + (size_t)row * DM + (i * 64 + lane) * 4) = xv[i];
      }
    }
    if (l < 4) {
      float ss = 0.f;
#pragma unroll
      for (int i = 0; i < 4; ++i) ss += xv[i].x * xv[i].x + xv[i].y * xv[i].y + xv[i].z * xv[i].z + xv[i].w * xv[i].w;
      ss = wsum(ss);
      const float rstd = rsqrtf(ss * (1.f / DM) + EPSV);
#pragma unroll
      for (int i = 0; i < 4; ++i) {
        const float4 g = *(const float4*)(p.norm_pre + l * DM + (i * 64 + lane) * 4);
        u32x2 o; o.x = pack2(xv[i].x * rstd * g.x, xv[i].y * rstd * g.y); o.y = pack2(xv[i].z * rstd * g.z, xv[i].w * rstd * g.w);
        *(u32x2*)(H + (size_t)row * LDH + (i * 64 + lane) * 4) = o;
      }
    }
  }
}

namespace pg8 {
#define PG8_LAS __attribute__((address_space(3)))
constexpr int BM = 256, BK = 64, HALF = 128, HTB = HALF * BK * 2, STAGE_BYTES = 8 * HTB, NXCD = 8, WGM = 8;
DI int lds_byte(int r, int c) { const int st = (r >> 4) * 2 + (c >> 5), rr = r & 15, cc = c & 31, ob = rr * 64 + cc * 2; return st * 1024 + (ob ^ (((ob >> 9) & 1) << 5)); }
DI void stage_rc(int b, int& R, int& C) { const int st = b / 1024, sb = b % 1024, swz = sb ^ (((sb >> 9) & 1) << 5); R = (st >> 1) * 16 + swz / 64; C = (st & 1) * 32 + (swz % 64) / 2; }
DI int perm32(int rho) { const int n = rho >> 4, i = rho & 15; return 8 * (i >> 2) + 4 * n + (i & 3); }
struct Unit { int pm, pn; };
struct Gemm { const u16* A; const u16* Bt; int M, N, K, ld; };
struct StaticOrder {
  int nM, nN, nwg, G, c;
  DI void init(int M, int N, int G_, int c_) { nM = M / BM; nN = N / BM; nwg = nM * nN; G = G_; c = c_; }
  DI bool next(int i, Unit& u) const {
    const long L = (long)i * G + c; if (L >= nwg) return false;
    int wgid = (int)L; { const int q = nwg / NXCD, r = nwg % NXCD, xcd = wgid % NXCD, off = wgid / NXCD; wgid = (xcd < r ? xcd * (q + 1) : r * (q + 1) + (xcd - r) * q) + off; }
    const int nig = WGM * nN, gid = wgid / nig, fm = gid * WGM, gsz = (nM - fm) < WGM ? (nM - fm) : WGM;
    u.pm = fm + ((wgid % nig) % gsz); u.pn = (wgid % nig) / gsz; return true;
  }
};
DI unsigned cvt_pk_bf16(float lo, float hi) { unsigned r; asm volatile("v_cvt_pk_bf16_f32 %0, %1, %2" : "=v"(r) : "v"(lo), "v"(hi)); return r; }
struct EpiF32 {
  static constexpr bool PERM = false;
  float* C; int ldc;
  DI void operator()(const f32x4 (&acc)[2][2][4][2], const Unit& u, int wr, int wc, int fr, int fq) const {
    const int row0 = u.pm * BM + wr * 64 + fr, col0 = u.pn * BM + wc * 32 + 4 * fq;
#pragma unroll
    for (int ai = 0; ai < 2; ++ai)
#pragma unroll
      for (int m = 0; m < 4; ++m) { float* rowp = C + (size_t)(row0 + ai * HALF + m * 16) * ldc + col0;
#pragma unroll
        for (int bj = 0; bj < 2; ++bj)
#pragma unroll
          for (int n = 0; n < 2; ++n) *(f32x4*)(rowp + bj * HALF + n * 16) = acc[ai][bj][m][n]; }
  }
};
struct EpiBf16 {
  static constexpr bool PERM = true;
  u16* O; int ldc;
  DI void operator()(const f32x4 (&acc)[2][2][4][2], const Unit& u, int wr, int wc, int fr, int fq) const {
    const int row0 = u.pm * BM + wr * 64 + fr, col0 = u.pn * BM + wc * 32 + 8 * fq;
#pragma unroll
    for (int ai = 0; ai < 2; ++ai)
#pragma unroll
      for (int m = 0; m < 4; ++m) { u16* rowp = O + (size_t)(row0 + ai * HALF + m * 16) * ldc + col0;
#pragma unroll
        for (int bj = 0; bj < 2; ++bj) { const f32x4 v0 = acc[ai][bj][m][0], v1 = acc[ai][bj][m][1];
          u32x4 w; w.x = cvt_pk_bf16(v0[0], v0[1]); w.y = cvt_pk_bf16(v0[2], v0[3]); w.z = cvt_pk_bf16(v1[0], v1[1]); w.w = cvt_pk_bf16(v1[2], v1[3]);
          *(u32x4*)(rowp + bj * HALF) = w; } }
  }
};
template <class Epi, class Sched>
DI void gemm_phase(PG8_LAS unsigned char* lds, const Gemm g, const Sched& S, const Epi& E) {
  int tid = threadIdx.x; asm volatile("" : "+v"(tid));
  const int wid = __builtin_amdgcn_readfirstlane(tid >> 6), lane = tid & 63, wr = wid >> 2, wc = wid & 3, fr = lane & 15, fq = lane >> 4;
  const int K = g.K, nt = K / BK, ld = g.ld;
  unsigned voffA[2], voffB[2];
#pragma unroll
  for (int i = 0; i < 2; ++i) { int R, C; stage_rc(tid * 16 + i * 8192, R, C); const int Rb = Epi::PERM ? ((R & ~31) + perm32(R & 31)) : R;
    voffA[i] = (unsigned)(R * ld + C) * 2u; voffB[i] = (unsigned)(Rb * ld + C) * 2u; }
  const size_t kstep = (size_t)(BK * 2);
  const size_t hstep = (size_t)HALF * ld * 2;
  const size_t tstep = 2 * hstep;
  const unsigned ldsw = (unsigned)wid * 1024u;
  const int aoff = lds_byte(wr * 64 + fr, fq * 8), boff = lds_byte(wc * 32 + fr, fq * 8);
#define PG8_SA(b, h) (((b) * 2 + (h)) * HTB)
#define PG8_SB(b, h) ((4 + (b) * 2 + (h)) * HTB)
#define PG8_STAGE(bufoff, gbase, voff) do { _Pragma("unroll") for (int _i = 0; _i < 2; ++_i) \
    __builtin_amdgcn_global_load_lds((const unsigned*)((const char*)(gbase) + (voff)[_i]), (PG8_LAS unsigned*)(lds + (bufoff) + ldsw + _i * 8192), 16, 0, 0); } while (0)
#define PG8_LDA(dst, b, h) do { _Pragma("unroll") for (int m = 0; m < 4; ++m) _Pragma("unroll") for (int k = 0; k < 2; ++k) dst[m][k] = *(const PG8_LAS bf16x8*)(lds + PG8_SA(b, h) + aoff + m * 2048 + k * 1024); } while (0)
#define PG8_LDB(dst, b, h) do { _Pragma("unroll") for (int n = 0; n < 2; ++n) _Pragma("unroll") for (int k = 0; k < 2; ++k) dst[n][k] = *(const PG8_LAS bf16x8*)(lds + PG8_SB(b, h) + boff + n * 2048 + k * 1024); } while (0)
#define PG8_MMA(ai, bj, At, Bt) do { __builtin_amdgcn_s_setprio(1); _Pragma("unroll") for (int m = 0; m < 4; ++m) _Pragma("unroll") for (int n = 0; n < 2; ++n) _Pragma("unroll") for (int k = 0; k < 2; ++k) \
    acc[ai][bj][m][n] = __builtin_amdgcn_mfma_f32_16x16x32_bf16(Bt[n][k], At[m][k], acc[ai][bj][m][n], 0, 0, 0); __builtin_amdgcn_s_setprio(0); } while (0)
#define PG8_WAIT_V(n) asm volatile("s_waitcnt vmcnt(" #n ")" ::: "memory")
#define PG8_WAIT_L(n) asm volatile("s_waitcnt lgkmcnt(" #n ")" ::: "memory")
#define PG8_BAR __builtin_amdgcn_s_barrier()
#define PG8_SCHED __builtin_amdgcn_sched_barrier(0)
  Unit cur, nxt; int ui = 0;
  if (!S.next(0, cur)) return;
  f32x4 acc[2][2][4][2];
#pragma unroll
  for (int a = 0; a < 2; ++a)
#pragma unroll
    for (int b = 0; b < 2; ++b)
#pragma unroll
      for (int m = 0; m < 4; ++m)
#pragma unroll
        for (int n = 0; n < 2; ++n) acc[a][b][m][n] = (f32x4){0.f, 0.f, 0.f, 0.f};
  bf16x8 At[4][2], B0[2][2], B1[2][2];
  const char* cA = (const char*)g.A + (size_t)cur.pm * tstep; const char* cB = (const char*)g.Bt + (size_t)cur.pn * tstep;
  PG8_STAGE(PG8_SB(0, 0), cB, voffB); PG8_STAGE(PG8_SA(0, 0), cA, voffA); PG8_STAGE(PG8_SB(0, 1), cB + hstep, voffB); PG8_STAGE(PG8_SA(0, 1), cA + hstep, voffA);
  if (wr == 1) PG8_BAR;
  PG8_WAIT_V(4); PG8_BAR;
  PG8_STAGE(PG8_SB(1, 0), cB + kstep, voffB); PG8_STAGE(PG8_SA(1, 0), cA + kstep, voffA); PG8_STAGE(PG8_SB(1, 1), cB + hstep + kstep, voffB);
  PG8_WAIT_V(6); PG8_BAR;
  for (;;) {
    const bool has_next = S.next(ui + 1, nxt);
    const char* nA = has_next ? (const char*)g.A + (size_t)nxt.pm * tstep : cA; const char* nB = has_next ? (const char*)g.Bt + (size_t)nxt.pn * tstep : cB;
    for (int t = 0; t < nt; t += 2) {
      const bool last = (t == nt - 2);
      const char* a1 = cA + (size_t)(t + 1) * kstep;
      const char* a2 = last ? nA : cA + (size_t)(t + 2) * kstep; const char* b2 = last ? nB : cB + (size_t)(t + 2) * kstep;
      const char* a3 = a2 + kstep; const char* b3 = b2 + kstep;
      PG8_LDB(B0, 0, 0); PG8_SCHED; PG8_LDA(At, 0, 0); PG8_STAGE(PG8_SA(1, 1), a1 + hstep, voffA);
      PG8_WAIT_L(8); PG8_BAR; PG8_WAIT_L(0); PG8_MMA(0, 0, At, B0); PG8_BAR; PG8_SCHED;
      PG8_LDB(B1, 0, 1); PG8_STAGE(PG8_SB(0, 0), b2, voffB);
      PG8_BAR; PG8_WAIT_L(0); PG8_MMA(0, 1, At, B1); PG8_BAR;
      PG8_LDA(At, 0, 1); PG8_STAGE(PG8_SA(0, 0), a2, voffA);
      PG8_BAR; PG8_WAIT_L(0); PG8_MMA(1, 0, At, B0); PG8_BAR; PG8_SCHED;
      PG8_STAGE(PG8_SB(0, 1), b2 + hstep, voffB);
      PG8_WAIT_V(6); PG8_BAR; PG8_MMA(1, 1, At, B1); PG8_BAR;
      PG8_LDB(B0, 1, 0); PG8_SCHED; PG8_LDA(At, 1, 0); PG8_STAGE(PG8_SA(0, 1), a2 + hstep, voffA);
      PG8_WAIT_L(8); PG8_BAR; PG8_WAIT_L(0); PG8_MMA(0, 0, At, B0); PG8_BAR; PG8_SCHED;
      PG8_LDB(B1, 1, 1); PG8_STAGE(PG8_SB(1, 0), b3, voffB);
      PG8_BAR; PG8_WAIT_L(0); PG8_MMA(0, 1, At, B1); PG8_BAR;
      PG8_LDA(At, 1, 1); PG8_STAGE(PG8_SA(1, 0), a3, voffA);
      PG8_BAR; PG8_WAIT_L(0); PG8_MMA(1, 0, At, B0); PG8_BAR; PG8_SCHED;
      PG8_STAGE(PG8_SB(1, 1), b3 + hstep, voffB);
      PG8_WAIT_V(6); PG8_BAR; PG8_MMA(1, 1, At, B1); PG8_BAR;
    }
    E(acc, cur, wr, wc, fr, fq);
    if (!has_next) break;
#pragma unroll
    for (int a = 0; a < 2; ++a)
#pragma unroll
      for (int b = 0; b < 2; ++b)
#pragma unroll
        for (int m = 0; m < 4; ++m)
#pragma unroll
          for (int n = 0; n < 2; ++n) acc[a][b][m][n] = (f32x4){0.f, 0.f, 0.f, 0.f};
    cur = nxt; cA = nA; cB = nB; ++ui;
  }
  PG8_WAIT_V(0);
  if (wr == 0) PG8_BAR;
  PG8_BAR;
#undef PG8_SA
#undef PG8_SB
#undef PG8_STAGE
#undef PG8_LDA
#undef PG8_LDB
#undef PG8_MMA
#undef PG8_WAIT_V
#undef PG8_WAIT_L
#undef PG8_BAR
#undef PG8_SCHED
}
}

DI void phase_inproj(const Params& p, int l, unsigned char* smem_base) {
  pg8::Gemm g; g.A = (const u16*)(p.ws + OFF_H); g.Bt = (const u16*)(p.ws + OFF_WIN) + (size_t)l * LDZ * LDH; g.M = MTOK; g.N = LDZ; g.K = DM; g.ld = LDH;
  pg8::StaticOrder S; S.init(MTOK, LDZ, gridDim.x, blockIdx.x);
  pg8::EpiBf16 E; E.O = (u16*)(p.ws + OFF_Z); E.ldc = LDZ;
  pg8::gemm_phase(( PG8_LAS unsigned char*)smem_base, g, S, E);
}

template <int NKT>
DI void attn_scores(f32x4 (&S)[NKT], const u16* sKw, const bf16x8 (&qf)[4], int lane) {
#pragma unroll
  for (int kt = 0; kt < NKT; ++kt) {
    S[kt] = f32x4{0.f, 0.f, 0.f, 0.f};
#pragma unroll
    for (int ks = 0; ks < 4; ++ks) {
      const bf16x8 kf = ldfrag(sKw + (kt * 16 + (lane & 15)) * 136 + ks * 32 + (lane >> 4) * 8);
      S[kt] = mfma16(kf, qf[ks], S[kt]);
    }
  }
}
template <int NKT>
DI void attn_pv(f32x4 (&O)[8], const f32x4 (&P)[NKT], const u16* sVTw, int ldv, int lane) {
#pragma unroll
  for (int ct = 0; ct < 8; ++ct) O[ct] = f32x4{0.f, 0.f, 0.f, 0.f};
#pragma unroll
  for (int pp = 0; pp < NKT / 2; ++pp) {
    bf16x8 pf;
#pragma unroll
    for (int j = 0; j < 4; ++j) { pf[j] = (short)f2bf(P[2 * pp][j]); pf[4 + j] = (short)f2bf(P[2 * pp + 1][j]); }
#pragma unroll
    for (int ct = 0; ct < 8; ++ct) {
      const u16* vp = sVTw + (ct * 16 + (lane & 15)) * ldv + (2 * pp) * 16 + (lane >> 4) * 4;
      const s16x4 lo = *(const s16x4*)vp;
      const s16x4 hi = *(const s16x4*)(vp + 16);
      const bf16x8 vf = __builtin_shufflevector(lo, hi, 0, 1, 2, 3, 4, 5, 6, 7);
      O[ct] = mfma16(vf, pf, O[ct]);
    }
  }
}

typedef short v4i16_t __attribute__((ext_vector_type(4)));
template <int NKT>
DI void attn_pv_tr(f32x4 (&O)[8], const f32x4 (&P)[NKT], const u16* sVw, int ldv, int lane) {
#pragma unroll
  for (int ct = 0; ct < 8; ++ct) O[ct] = f32x4{0.f, 0.f, 0.f, 0.f};
#pragma unroll
  for (int pp = 0; pp < NKT / 2; ++pp) {
    bf16x8 pf;
#pragma unroll
    for (int j = 0; j < 4; ++j) { pf[j] = (short)f2bf(P[2 * pp][j]); pf[4 + j] = (short)f2bf(P[2 * pp + 1][j]); }
    const u16* vrow = sVw + ((2 * pp) * 16 + (lane >> 4) * 4 + ((lane & 15) >> 2)) * ldv + (lane & 3) * 4;
#pragma unroll
    for (int ct = 0; ct < 8; ++ct) {
      const s16x4 lo = __builtin_bit_cast(s16x4, __builtin_amdgcn_ds_read_tr16_b64_v4i16((__attribute__((address_space(3))) v4i16_t*)(vrow + ct * 16)));
      const s16x4 hi = __builtin_bit_cast(s16x4, __builtin_amdgcn_ds_read_tr16_b64_v4i16((__attribute__((address_space(3))) v4i16_t*)(vrow + 16 * ldv + ct * 16)));
      const bf16x8 vf = __builtin_shufflevector(lo, hi, 0, 1, 2, 3, 4, 5, 6, 7);
      O[ct] = mfma16(vf, pf, O[ct]);
    }
  }
}

DI void unit_attnA(const Params& p, const Bucket& bk, const SB& sb, int u, unsigned char* smem, int dry) {
  u16* Z = (u16*)(p.ws + OFF_Z);
  float* LSE = (float*)(p.ws + OFF_LSE);
  u16* sK = (u16*)smem;
  float* sBias = (float*)(smem + 59904);
  const int tid = TIDX(), lane = tid & 63, w = tid >> 6;
  const int L = sb.L, B = sb.B, nblk = L / 64;
  const int blk = u % nblk; int t = u / nblk; const int b = t % B; const int gh = t / B; const int g = gh >> 2, h = gh & 3;
  const int d = (g == 0) ? 1 : (g == 1 ? 4 : 16);
  const int M = L / d, nbr = M / 64, r = blk / nbr, m0 = (blk % nbr) * 64;
  const size_t rowbase = (size_t)b * L;
  const int qcol = C_QA + g * 512 + h * 128, kcol = C_KA + g * 512 + h * 128, vcol = C_VA + g * 512 + h * 128;
  __syncthreads();
  if (tid < 129) sBias[tid] = ((const float*)(p.ws + OFF_DFT + 98304))[(g * 4 + h) * 129 + tid];
  for (int id = tid; id < 208 * 16; id += 256) {
    const int kk = id >> 4, ch = id & 15;
    const int km = m0 - 64 + kk;
    const int kmc = min(max(km, 0), M - 1);
    u32x4 v = *(const u32x4*)(Z + (rowbase + (size_t)kmc * d + r) * LDZ + kcol + ch * 8);
    if (km != kmc) v = u32x4{0u, 0u, 0u, 0u};
    *(u32x4*)(sK + kk * 136 + ch * 8) = v;
  }
  bf16x8 qf[4];
  const size_t qrow = rowbase + (size_t)(m0 + w * 16 + (lane & 15)) * d + r;
#pragma unroll
  for (int ks = 0; ks < 4; ++ks) qf[ks] = ldfrag(Z + qrow * LDZ + qcol + ks * 32 + (lane >> 4) * 8);
  u32x4 vreg[13];
#pragma unroll
  for (int i = 0; i < 13; ++i) {
    const int id = tid + i * 256, kk = id >> 4, ch = id & 15;
    const int km = m0 - 64 + kk;
    const int kmc = min(max(km, 0), M - 1);
    vreg[i] = *(const u32x4*)(Z + (rowbase + (size_t)kmc * d + r) * LDZ + vcol + ch * 8);
    if (km != kmc) vreg[i] = u32x4{0u, 0u, 0u, 0u};
  }
  __syncthreads();
  f32x4 S[10];
  attn_scores<10>(S, sK + (w * 16) * 136, qf, lane);
  float mx = -3.0e38f;
#pragma unroll
  for (int kt = 0; kt < 10; ++kt)
#pragma unroll
    for (int i = 0; i < 4; ++i) {
      const int kkr = kt * 16 + (lane >> 4) * 4 + i;
      const int rel = kkr - 64 - (lane & 15);
      const int km = m0 - 64 + w * 16 + kkr;
      const bool ok = (rel >= -64) && (rel <= 64) && (km >= 0) && (km < M);
      const int bi = min(max(rel + 64, 0), 128);
      const float s = ok ? S[kt][i] * QSCALE + sBias[bi] : -1e30f;
      S[kt][i] = s;
      mx = fmaxf(mx, s);
    }
  mx = fmaxf(mx, __shfl_xor(mx, 16));
  mx = fmaxf(mx, __shfl_xor(mx, 32));
  float sum = 0.f;
#pragma unroll
  for (int kt = 0; kt < 10; ++kt)
#pragma unroll
    for (int i = 0; i < 4; ++i) { const float e = __expf(S[kt][i] - mx); S[kt][i] = e; sum += e; }
  sum += __shfl_xor(sum, 16);
  sum += __shfl_xor(sum, 32);
  __syncthreads();
  u16* sV = sK;
#pragma unroll
  for (int i = 0; i < 13; ++i) {
    const int id = tid + i * 256, kk = id >> 4, ch = id & 15;
    *(u32x4*)(sV + kk * 144 + ch * 8) = vreg[i];
  }
  __syncthreads();
  f32x4 O[8];
  attn_pv_tr<10>(O, S, sV + (w * 16) * 144, 144, lane);
  const float inv = 1.f / sum;
  if (!dry) {
#pragma unroll
    for (int ct = 0; ct < 8; ++ct) {
      u32x2 o; o.x = pack2(O[ct][0] * inv, O[ct][1] * inv); o.y = pack2(O[ct][2] * inv, O[ct][3] * inv);
      *(u32x2*)(Z + qrow * LDZ + qcol + ct * 16 + (lane >> 4) * 4) = o;
    }
  }
  if ((lane >> 4) == 0) LSE[qrow * 12 + g * 4 + h] = mx + __logf(sum);
}

DI void unit_attnD(const Params& p, const SB& sb, int l, int u, unsigned char* smem) {
  const u16* Z = (const u16*)(p.ws + OFF_Z);
  u16* GATED = (u16*)(p.ws + OFF_GATED);
  u16* sK = (u16*)smem;
  const int tid = TIDX(), lane = tid & 63, w = tid >> 6;
  const int h = u & 3, rb = u >> 2;
  const int row0 = rb * 64;
  const int b = row0 / sb.L;
  const size_t kvbase = ((size_t)(l * 6 + sb.memb + b) * 4 + h) * 256 * 128;
  const u16* KVK = (const u16*)(p.ws + OFF_KVK) + kvbase;
  const u16* KVV = (const u16*)(p.ws + OFF_KVV) + kvbase;
  __syncthreads();
  for (int id = tid; id < 256 * 16; id += 256) {
    const int m = id >> 4, ch = id & 15;
    *(u32x4*)(sK + m * 136 + ch * 8) = *(const u32x4*)(KVK + m * 128 + ch * 8);
  }
  bf16x8 qf[4];
  const size_t qrow = (size_t)row0 + w * 16 + (lane & 15);
#pragma unroll
  for (int ks = 0; ks < 4; ++ks) qf[ks] = ldfrag(Z + qrow * LDZ + C_QD + h * 128 + ks * 32 + (lane >> 4) * 8);
  __syncthreads();
  f32x4 S[16];
  attn_scores<16>(S, sK, qf, lane);
  float mx = -3.0e38f;
#pragma unroll
  for (int kt = 0; kt < 16; ++kt)
#pragma unroll
    for (int i = 0; i < 4; ++i) { S[kt][i] *= QSCALE; mx = fmaxf(mx, S[kt][i]); }
  mx = fmaxf(mx, __shfl_xor(mx, 16));
  mx = fmaxf(mx, __shfl_xor(mx, 32));
  float sum = 0.f;
#pragma unroll
  for (int kt = 0; kt < 16; ++kt)
#pragma unroll
    for (int i = 0; i < 4; ++i) { const float e = __expf(S[kt][i] - mx); S[kt][i] = e; sum += e; }
  sum += __shfl_xor(sum, 16);
  sum += __shfl_xor(sum, 32);
  __syncthreads();
  u16* sVT = sK;
  for (int id = tid; id < 128 * 32; id += 256) {
    const int c = id >> 5, ch = id & 31;
    *(u32x4*)(sVT + c * 264 + ch * 8) = *(const u32x4*)(KVV + c * 256 + ch * 8);
  }
  __syncthreads();
  f32x4 O[8];
  attn_pv<16>(O, S, sVT, 264, lane);
  const float inv = 1.f / sum;
#pragma unroll
  for (int ct = 0; ct < 8; ++ct) {
    const int c = h * 128 + ct * 16 + (lane >> 4) * 4;
    u32x2 o;
    o.x = pack2(O[ct][0] * inv, O[ct][1] * inv);
    o.y = pack2(O[ct][2] * inv, O[ct][3] * inv);
    *(u32x2*)(GATED + qrow * LDG + 1536 + c) = o;
  }
}

DI void conv8(const u16* __restrict__ Zb, int L, int pos, int col, const float* __restrict__ cw, int cwcol, float (&o)[8]) {
  float a[8];
#pragma unroll
  for (int e = 0; e < 8; ++e) a[e] = 0.f;
  u32x4 zv[5];
#pragma unroll
  for (int j = 0; j < 5; ++j) {
    const int pp = min(max(pos + j - 2, 0), L - 1);
    zv[j] = *(const u32x4*)(Zb + (size_t)pp * LDZ + col);
  }
#pragma unroll
  for (int j = 0; j < 5; ++j) {
    const int pp = pos + j - 2;
    const float ok = (pp >= 0 && pp < L) ? 1.f : 0.f;
    float f[8];
    unpack8(zv[j], f);
    const float4 w0 = *(const float4*)(cw + j * 1024 + cwcol);
    const float4 w1 = *(const float4*)(cw + j * 1024 + cwcol + 4);
    a[0] += f[0] * (w0.x * ok); a[1] += f[1] * (w0.y * ok); a[2] += f[2] * (w0.z * ok); a[3] += f[3] * (w0.w * ok);
    a[4] += f[4] * (w1.x * ok); a[5] += f[5] * (w1.y * ok); a[6] += f[6] * (w1.z * ok); a[7] += f[7] * (w1.w * ok);
  }
#pragma unroll
  for (int e = 0; e < 8; ++e) o[e] = siluf_(a[e]);
}
DI void gate_stats(const Params& p, const u16* Zrow0  , int l, int h, int dir, int lane, int& t, float& bcum, float& uu, float& g) {
  t = dir ? 63 - lane : lane;
  const u16* zr = Zrow0 + (size_t)t * LDZ + C_GC + dir * 8 + h;
  const float ip = bf2f(zr[0]) + p.gate_bias[l * 16 + dir * 8 + h];
  const float fp = bf2f(zr[4]) + p.gate_bias[l * 16 + dir * 8 + 4 + h];
  float v = logsigf_(fp);
#pragma unroll
  for (int o = 1; o < 64; o <<= 1) { const float n = __shfl_up(v, o); if (lane >= o) v += n; }
  bcum = v;
  g = __shfl(v, 63);
  uu = ip - v;
}

DI void unit_mlstm_local(const Params& p, const SB& sb, int l, int u, unsigned char* smem) {
  const u16* Z = (const u16*)(p.ws + OFF_Z);
  u16* CS = (u16*)(p.ws + OFF_CS);
  float* NS = (float*)(p.ws + OFF_NS);
  float* SCG = (float*)(p.ws + OFF_SC);
  float* SCMA = SCG + 2048;
  u16* sKW = (u16*)smem;
  u16* sVT = sKW + 2 * 128 * 72;
  float* sWa = (float*)(sVT + 128 * 72);
  const int tid = TIDX(), lane = tid & 63, w = tid >> 6;
  const int N = sb.L / 64;
  const int h = u & 3; int cidx = u >> 2; const int n = cidx % N, b = cidx / N;
  const size_t row0 = (size_t)b * sb.L + (size_t)n * 64;
  __syncthreads();
  if (w < 2) {
    int t; float bc, uu, g;
    gate_stats(p, Z + row0 * LDZ, l, h, w, lane, t, bc, uu, g);
    const float a = g + uu;
    const float ma = wmaxr(a);
    sWa[w * 64 + t] = __expf(a - ma);
    if (lane == 0) { const int seq = (b * 4 + h) * 2 + w; SCG[seq * N + n] = g; SCMA[seq * N + n] = ma; }
  }
  __syncthreads();
  const u16* Zb = Z + (size_t)b * sb.L * LDZ;
  const float* cw = p.conv_qk + (size_t)l * 5 * 1024;
#pragma unroll 1
  for (int i = 0; i < 4; ++i) {
    const int id = tid + i * 256, t = id & 63, ch = id >> 6;
    float km[8];
    conv8(Zb, sb.L, n * 64 + t, C_KC + h * 128 + ch * 8, cw, 512 + h * 128 + ch * 8, km);
    const float wf = sWa[t], wb = sWa[64 + t];
    const u32x4 vv = *(const u32x4*)(Z + (row0 + t) * LDZ + C_VC + h * 128 + ch * 8);
    const unsigned vw[4] = {vv.x, vv.y, vv.z, vv.w};
#pragma unroll
    for (int e = 0; e < 8; ++e) {
      sKW[(ch * 8 + e) * 72 + t] = f2bf(km[e] * wf);
      sKW[(128 + ch * 8 + e) * 72 + t] = f2bf(km[e] * wb);
      sVT[(ch * 8 + e) * 72 + t] = (u16)((e & 1) ? (vw[e >> 1] >> 16) : (vw[e >> 1] & 0xffff));
    }
  }
  __syncthreads();
  {
    const int dir = tid >> 7, dd = tid & 127;
    float s = 0.f;
    const u16* kp = sKW + (dir * 128 + dd) * 72;
#pragma unroll 8
    for (int t = 0; t < 64; ++t) s += bf2f(kp[t]);
    const int seq = (b * 4 + h) * 2 + dir;
    NS[((size_t)seq * N + n) * 128 + dd] = s;
  }
#pragma unroll 1
  for (int dir = 0; dir < 2; ++dir) {
    f32x4 acc[2][8];
#pragma unroll
    for (int a = 0; a < 2; ++a)
#pragma unroll
      for (int c = 0; c < 8; ++c) acc[a][c] = f32x4{0.f, 0.f, 0.f, 0.f};
#pragma unroll
    for (int ks = 0; ks < 2; ++ks) {
      bf16x8 af[2], bfv[8];
#pragma unroll
      for (int mt = 0; mt < 2; ++mt) af[mt] = ldfrag(sKW + (dir * 128 + w * 32 + mt * 16 + (lane & 15)) * 72 + ks * 32 + (lane >> 4) * 8);
#pragma unroll
      for (int nt = 0; nt < 8; ++nt) bfv[nt] = ldfrag(sVT + (nt * 16 + (lane & 15)) * 72 + ks * 32 + (lane >> 4) * 8);
#pragma unroll
      for (int mt = 0; mt < 2; ++mt)
#pragma unroll
        for (int nt = 0; nt < 8; ++nt) acc[mt][nt] = mfma16(af[mt], bfv[nt], acc[mt][nt]);
    }
    const int seq = (b * 4 + h) * 2 + dir;
    u16* cs = CS + ((size_t)seq * N + n) * 16384;
#pragma unroll
    for (int mt = 0; mt < 2; ++mt)
#pragma unroll
      for (int nt = 0; nt < 8; ++nt) {
        const int e = nt * 16 + (lane & 15), dd = w * 32 + mt * 16 + (lane >> 4) * 4;
        u32x2 o; o.x = pack2(acc[mt][nt][0], acc[mt][nt][1]); o.y = pack2(acc[mt][nt][2], acc[mt][nt][3]);
        *(u32x2*)(cs + e * 128 + dd) = o;
      }
  }
}

DI void unit_mlstm_scan(const Params& p, const SB& sb, int u, unsigned char* smem, int dry) {
  u16* CS = (u16*)(p.ws + OFF_CS);
  float* NS = (float*)(p.ws + OFF_NS);
  const float* SCG = (const float*)(p.ws + OFF_SC);
  const float* SCMA = SCG + 2048;
  float* SCMP = (float*)(p.ws + OFF_SC) + 4096;
  float* sOld = (float*)smem;
  float* sNew = sOld + 256;
  const int tid = TIDX();
  const int N = sb.L / 64;
  const int seq = u >> 5, slab = u & 31, dir = seq & 1;
  __syncthreads();
  if (tid < N) { sOld[tid] = SCG[seq * N + tid]; sNew[tid] = SCMA[seq * N + tid]; }
  __syncthreads();
  if (tid == 0) {
    float m = 0.f;
    for (int i = 0; i < N; ++i) {
      const int n = dir ? N - 1 - i : i;
      const float g = sOld[n], ma = sNew[n];
      const float mn = fmaxf(g + m, ma);
      sOld[n] = __expf(g + m - mn);
      sNew[n] = __expf(ma - mn);
      if (slab == 0) SCMP[seq * N + n] = m;
      m = mn;
    }
  }
  __syncthreads();
  unsigned* cs = (unsigned*)(CS + (size_t)seq * N * 16384) + slab * 256 + tid;
  float c0 = 0.f, c1 = 0.f;
  for (int i0 = 0; i0 < N; i0 += 32) {
    unsigned v[32];
#pragma unroll
    for (int j = 0; j < 32; ++j) { const int n = dir ? N - 1 - (i0 + j) : i0 + j; v[j] = cs[(size_t)n * 8192]; }
#pragma unroll
    for (int j = 0; j < 32; ++j) {
      const int n = dir ? N - 1 - (i0 + j) : i0 + j;
      if (!dry) cs[(size_t)n * 8192] = pack2(c0, c1);
      const float so = sOld[n], sn = sNew[n];
      c0 = so * c0 + sn * bflo(v[j]);
      c1 = so * c1 + sn * bfhi(v[j]);
    }
  }
  if (slab == 0 && tid < 128) {
    float* ns = NS + (size_t)seq * N * 128 + tid;
    float a = 0.f;
    for (int i0 = 0; i0 < N; i0 += 16) {
      float v[16];
#pragma unroll
      for (int j = 0; j < 16; ++j) { const int n = dir ? N - 1 - (i0 + j) : i0 + j; v[j] = ns[(size_t)n * 128]; }
#pragma unroll
      for (int j = 0; j < 16; ++j) {
        const int n = dir ? N - 1 - (i0 + j) : i0 + j;
        if (!dry) ns[(size_t)n * 128] = a;
        a = sOld[n] * a + sNew[n] * v[j];
      }
    }
  }
}

DI void unit_mlstm_out(const Params& p, const SB& sb, int l, int u, unsigned char* smem) {
  const u16* Z = (const u16*)(p.ws + OFF_Z);
  const u16* CS = (const u16*)(p.ws + OFF_CS);
  const float* NS = (const float*)(p.ws + OFF_NS);
  const float* SCMP = (const float*)(p.ws + OFF_SC) + 4096;
  u16* GATED = (u16*)(p.ws + OFF_GATED);
  u16* sQ = (u16*)smem;
  u16* sK = sQ + 64 * 136;
  u16* sV = sK + 64 * 136;
  u16* sSQ = sV + 64 * 144;
  float* sU = (float*)(sSQ + 64 * 72);
  float* sMx = sU + 128;
  float* sB = sMx + 128;
  float* sNp = sB + 128;
  float* sMp = sNp + 256;
  const int tid = TIDX(), lane = tid & 63, w = tid >> 6;
  const int N = sb.L / 64;
  const int h = u & 3; int cidx = u >> 2; const int n = cidx % N, b = cidx / N;
  const size_t row0 = (size_t)b * sb.L + (size_t)n * 64;
  const int seq0 = (b * 4 + h) * 2;
  __syncthreads();
  if (w < 2) {
    int t; float bc, uu, g;
    gate_stats(p, Z + row0 * LDZ, l, h, w, lane, t, bc, uu, g);
    float pm = uu;
#pragma unroll
    for (int o = 1; o < 64; o <<= 1) { const float nn = __shfl_up(pm, o); if (lane >= o) pm = fmaxf(pm, nn); }
    const float mp = SCMP[(seq0 + w) * N + n];
    sU[w * 64 + t] = uu;
    sMx[w * 64 + t] = fmaxf(mp, pm);
    sB[w * 64 + t] = bc;
    if (lane == 0) sMp[w] = mp;
  }
  {
    const int dir = tid >> 7, dd = tid & 127;
    sNp[tid] = NS[((size_t)(seq0 + dir) * N + n) * 128 + dd];
  }
  const u16* Zb = Z + (size_t)b * sb.L * LDZ;
  const float* cw = p.conv_qk + (size_t)l * 5 * 1024;
#pragma unroll 1
  for (int i = 0; i < 4; ++i) {
    const int id = tid + i * 256, ch = id & 15, t = id >> 4;
    float qm[8], km[8];
    const u32x4 vv = *(const u32x4*)(Z + (row0 + t) * LDZ + C_VC + h * 128 + ch * 8);
    conv8(Zb, sb.L, n * 64 + t, C_QC + h * 128 + ch * 8, cw, h * 128 + ch * 8, qm);
    conv8(Zb, sb.L, n * 64 + t, C_KC + h * 128 + ch * 8, cw, 512 + h * 128 + ch * 8, km);
    u32x4 qo, ko;
    qo.x = pack2(qm[0] * QSCALE, qm[1] * QSCALE); qo.y = pack2(qm[2] * QSCALE, qm[3] * QSCALE);
    qo.z = pack2(qm[4] * QSCALE, qm[5] * QSCALE); qo.w = pack2(qm[6] * QSCALE, qm[7] * QSCALE);
    ko.x = pack2(km[0], km[1]); ko.y = pack2(km[2], km[3]); ko.z = pack2(km[4], km[5]); ko.w = pack2(km[6], km[7]);
    *(u32x4*)(sQ + t * 136 + ch * 8) = qo;
    *(u32x4*)(sK + t * 136 + ch * 8) = ko;
    *(u32x4*)(sV + t * 144 + ch * 8) = vv;
  }
  __syncthreads();
  const int tq = w * 16 + (lane & 15);
  f32x4 S[4];
  {
    bf16x8 qf[4];
#pragma unroll
    for (int ks = 0; ks < 4; ++ks) qf[ks] = ldfrag(sQ + tq * 136 + ks * 32 + (lane >> 4) * 8);
#pragma unroll
    for (int mt = 0; mt < 4; ++mt) {
      S[mt] = f32x4{0.f, 0.f, 0.f, 0.f};
#pragma unroll
      for (int ks = 0; ks < 4; ++ks) {
        const bf16x8 kf = ldfrag(sK + (mt * 16 + (lane & 15)) * 136 + ks * 32 + (lane >> 4) * 8);
        S[mt] = mfma16(kf, qf[ks], S[mt]);
      }
    }
  }
  f32x4 hc[8];
#pragma unroll
  for (int mt = 0; mt < 8; ++mt) hc[mt] = f32x4{0.f, 0.f, 0.f, 0.f};
#pragma unroll 1
  for (int dir = 0; dir < 2; ++dir) {
    const float Mx = sMx[dir * 64 + tq];
    const float mp = sMp[dir];
    const float winter = __expf(mp - Mx);
    const float em = __expf(-(sB[dir * 64 + tq] + Mx));
    float dq = 0.f;
    {
      const u16* qp = sQ + tq * 136 + (lane >> 4) * 32;
      const float* np_ = sNp + dir * 128 + (lane >> 4) * 32;
#pragma unroll 8
      for (int j = 0; j < 32; ++j) dq += bf2f(qp[j]) * np_[j];
    }
    dq += __shfl_xor(dq, 16);
    dq += __shfl_xor(dq, 32);
    float dsum = 0.f;
    __syncthreads();
#pragma unroll
    for (int mt = 0; mt < 4; ++mt) {
      float v[4];
#pragma unroll
      for (int i = 0; i < 4; ++i) {
        const int s = mt * 16 + (lane >> 4) * 4 + i;
        const bool ok = dir ? (s >= tq) : (s <= tq);
        const float wi = ok ? __expf(fminf(sU[dir * 64 + s] - Mx, 0.f)) : 0.f;
        v[i] = S[mt][i] * wi;
        dsum += v[i];
      }
      u32x2 o; o.x = pack2(v[0], v[1]); o.y = pack2(v[2], v[3]);
      *(u32x2*)(sSQ + tq * 72 + mt * 16 + (lane >> 4) * 4) = o;
    }
    dsum += __shfl_xor(dsum, 16);
    dsum += __shfl_xor(dsum, 32);
    const float den = winter * dq + dsum;
    const float rden = 1.f / fmaxf(fabsf(den), em);
    __syncthreads();
    const u16* cs = CS + ((size_t)(seq0 + dir) * N + n) * 16384;
    f32x4 acc[8];
#pragma unroll
    for (int mt = 0; mt < 8; ++mt) acc[mt] = f32x4{0.f, 0.f, 0.f, 0.f};
#pragma unroll
    for (int ks = 0; ks < 4; ++ks) {
      const bf16x8 qf = ldfrag(sQ + tq * 136 + ks * 32 + (lane >> 4) * 8);
#pragma unroll
      for (int mt = 0; mt < 8; ++mt) {
        const bf16x8 cf = ldfrag(cs + (mt * 16 + (lane & 15)) * 128 + ks * 32 + (lane >> 4) * 8);
        acc[mt] = mfma16(cf, qf, acc[mt]);
      }
    }
#pragma unroll
    for (int mt = 0; mt < 8; ++mt)
#pragma unroll
      for (int i = 0; i < 4; ++i) acc[mt][i] *= winter;
#pragma unroll
    for (int ks = 0; ks < 2; ++ks) {
      const bf16x8 pf = ldfrag(sSQ + tq * 72 + ks * 32 + (lane >> 4) * 8);
#pragma unroll
      for (int mt = 0; mt < 8; ++mt) {
        const u16* vp = sV + (ks * 32 + (lane >> 4) * 8 + ((lane & 15) >> 2)) * 144 + mt * 16 + (lane & 3) * 4;
        const s16x4 vlo = __builtin_bit_cast(s16x4, __builtin_amdgcn_ds_read_tr16_b64_v4i16((__attribute__((address_space(3))) v4i16_t*)vp));
        const s16x4 vhi = __builtin_bit_cast(s16x4, __builtin_amdgcn_ds_read_tr16_b64_v4i16((__attribute__((address_space(3))) v4i16_t*)(vp + 4 * 144)));
        const bf16x8 vf = __builtin_shufflevector(vlo, vhi, 0, 1, 2, 3, 4, 5, 6, 7);
        acc[mt] = mfma16(vf, pf, acc[mt]);
      }
    }
#pragma unroll
    for (int mt = 0; mt < 8; ++mt)
#pragma unroll
      for (int i = 0; i < 4; ++i) hc[mt][i] += acc[mt][i] * rden;
  }
  const size_t row = row0 + tq;
  float s1 = 0.f;
#pragma unroll
  for (int mt = 0; mt < 8; ++mt) {
    const u32x2 oc = *(const u32x2*)(Z + row * LDZ + C_OC + h * 128 + mt * 16 + (lane >> 4) * 4);
    hc[mt][0] *= sigmoidf_(bflo(oc.x)); hc[mt][1] *= sigmoidf_(bfhi(oc.x));
    hc[mt][2] *= sigmoidf_(bflo(oc.y)); hc[mt][3] *= sigmoidf_(bfhi(oc.y));
    s1 += hc[mt][0] + hc[mt][1] + hc[mt][2] + hc[mt][3];
  }
  s1 += __shfl_xor(s1, 16);
  s1 += __shfl_xor(s1, 32);
  const float mu = s1 * (1.f / 128.f);
  float s2 = 0.f;
#pragma unroll
  for (int mt = 0; mt < 8; ++mt)
#pragma unroll
    for (int i = 0; i < 4; ++i) { const float dlt = hc[mt][i] - mu; s2 += dlt * dlt; }
  s2 += __shfl_xor(s2, 16);
  s2 += __shfl_xor(s2, 32);
  const float rs = rsqrtf(s2 * (1.f / 128.f) + EPSV);
#pragma unroll
  for (int mt = 0; mt < 8; ++mt) {
    const int c = h * 128 + mt * 16 + (lane >> 4) * 4;
    const float4 hg = *(const float4*)(p.head_gain + l * 512 + c);
    const u32x2 gp = *(const u32x2*)(Z + row * LDZ + C_GP + 2 * 512 + c);
    u32x2 o;
    o.x = pack2((hc[mt][0] - mu) * rs * hg.x * siluf_(bflo(gp.x)), (hc[mt][1] - mu) * rs * hg.y * siluf_(bfhi(gp.x)));
    o.y = pack2((hc[mt][2] - mu) * rs * hg.z * siluf_(bflo(gp.y)), (hc[mt][3] - mu) * rs * hg.w * siluf_(bfhi(gp.y)));
    *(u32x2*)(GATED + row * LDG + 1024 + c) = o;
  }
}

template <int N1>
DI void unit_fft1(const Params& p, const SB& sb, int u, unsigned char* smem) {
  constexpr int N2 = N1;
  constexpr int LDU = N1 + 8;
  constexpr int MTW = N1 / 64;
  const u16* Z = (const u16*)(p.ws + OFF_Z);
  const u16* DFT = (const u16*)(p.ws + OFF_DFT);
  const u16* DC128 = DFT, *DS128 = DFT + 16384;
  const u16* DC1 = (N1 == 128) ? DFT : DFT + 32768;
  const u16* DS1 = (N1 == 128) ? DFT + 16384 : DFT + 36864;
  u16* HR = (u16*)(p.ws + OFF_OUT);
  u16* HI = HR + (size_t)MTOK * 512;
  u16* sX = (u16*)smem;
  u16* sUT = sX + 128 * 136;
  u16* sVT = sUT + 64 * 136;
  const int tid = TIDX(), lane = tid & 63, w = tid >> 6;
  const int qh = u & 1, g4 = (u >> 1) & 3; int t2 = u >> 3; const int n2 = t2 % N2, b = t2 / N2;
  const int L = sb.L;
  __syncthreads();
  for (int id = tid; id < N1 * 16; id += 256) {
    const int n1 = id >> 4, ch = id & 15;
    *(u32x4*)(sX + n1 * 136 + ch * 8) = *(const u32x4*)(Z + ((size_t)b * L + (size_t)N2 * n1 + n2) * LDZ + C_XB + g4 * 128 + ch * 8);
  }
  __syncthreads();
  {
    f32x4 au[MTW][4], av[MTW][4];
#pragma unroll
    for (int a = 0; a < MTW; ++a)
#pragma unroll
      for (int c = 0; c < 4; ++c) { au[a][c] = f32x4{0.f, 0.f, 0.f, 0.f}; av[a][c] = f32x4{0.f, 0.f, 0.f, 0.f}; }
#pragma unroll
    for (int ks = 0; ks < 4; ++ks) {
      bf16x8 xf[MTW], cf[4], sf[4];
#pragma unroll
      for (int mt = 0; mt < MTW; ++mt) xf[mt] = ldfrag(sX + ((w * MTW + mt) * 16 + (lane & 15)) * 136 + ks * 32 + (lane >> 4) * 8);
#pragma unroll
      for (int nt = 0; nt < 4; ++nt) {
        const int q = qh * 64 + nt * 16 + (lane & 15);
        cf[nt] = ldfrag(DC128 + q * 128 + ks * 32 + (lane >> 4) * 8);
        sf[nt] = ldfrag(DS128 + q * 128 + ks * 32 + (lane >> 4) * 8);
      }
#pragma unroll
      for (int mt = 0; mt < MTW; ++mt)
#pragma unroll
        for (int nt = 0; nt < 4; ++nt) { au[mt][nt] = mfma16(xf[mt], cf[nt], au[mt][nt]); av[mt][nt] = mfma16(xf[mt], sf[nt], av[mt][nt]); }
    }
#pragma unroll
    for (int mt = 0; mt < MTW; ++mt)
#pragma unroll
      for (int nt = 0; nt < 4; ++nt) {
        const int ql = nt * 16 + (lane & 15), n1 = (w * MTW + mt) * 16 + (lane >> 4) * 4;
        u32x2 o; o.x = pack2(au[mt][nt][0], au[mt][nt][1]); o.y = pack2(au[mt][nt][2], au[mt][nt][3]);
        *(u32x2*)(sUT + ql * LDU + n1) = o;
        o.x = pack2(av[mt][nt][0], av[mt][nt][1]); o.y = pack2(av[mt][nt][2], av[mt][nt][3]);
        *(u32x2*)(sVT + ql * LDU + n1) = o;
      }
  }
  __syncthreads();
  f32x4 gr[MTW][4], gi[MTW][4];
#pragma unroll
  for (int a = 0; a < MTW; ++a)
#pragma unroll
    for (int c = 0; c < 4; ++c) { gr[a][c] = f32x4{0.f, 0.f, 0.f, 0.f}; gi[a][c] = f32x4{0.f, 0.f, 0.f, 0.f}; }
#pragma unroll
  for (int ks = 0; ks < N1 / 32; ++ks) {
    bf16x8 uf[4], vf[4];
#pragma unroll
    for (int nt = 0; nt < 4; ++nt) {
      uf[nt] = ldfrag(sUT + (nt * 16 + (lane & 15)) * LDU + ks * 32 + (lane >> 4) * 8);
      vf[nt] = ldfrag(sVT + (nt * 16 + (lane & 15)) * LDU + ks * 32 + (lane >> 4) * 8);
    }
#pragma unroll
    for (int mt = 0; mt < MTW; ++mt) {
      const int k1 = (w * MTW + mt) * 16 + (lane & 15);
      const bf16x8 cf = ldfrag(DC1 + k1 * N1 + ks * 32 + (lane >> 4) * 8);
      const bf16x8 sf = ldfrag(DS1 + k1 * N1 + ks * 32 + (lane >> 4) * 8);
      const bf16x8 sn = negfrag(sf);
#pragma unroll
      for (int nt = 0; nt < 4; ++nt) {
        gr[mt][nt] = mfma16(uf[nt], cf, gr[mt][nt]);
        gr[mt][nt] = mfma16(vf[nt], sn, gr[mt][nt]);
        gi[mt][nt] = mfma16(uf[nt], sf, gi[mt][nt]);
        gi[mt][nt] = mfma16(vf[nt], cf, gi[mt][nt]);
      }
    }
  }
  const float sc = rsqrtf((float)(N1 * 128));
#pragma unroll
  for (int mt = 0; mt < MTW; ++mt) {
    const int k1 = (w * MTW + mt) * 16 + (lane & 15);
    const float ang = 2.f * (float)((n2 * k1) % L) / (float)L;
    const float cph = cospif(ang) * sc, sph = sinpif(ang) * sc;
    const size_t base = (((size_t)b * N1 + k1) * N2 + n2) * 512 + g4 * 128 + qh * 64;
#pragma unroll
    for (int nt = 0; nt < 4; ++nt) {
      float hr[4], hi[4];
#pragma unroll
      for (int i = 0; i < 4; ++i) { hr[i] = gr[mt][nt][i] * cph - gi[mt][nt][i] * sph; hi[i] = gr[mt][nt][i] * sph + gi[mt][nt][i] * cph; }
      u32x2 o; o.x = pack2(hr[0], hr[1]); o.y = pack2(hr[2], hr[3]);
      *(u32x2*)(HR + base + nt * 16 + (lane >> 4) * 4) = o;
      o.x = pack2(hi[0], hi[1]); o.y = pack2(hi[2], hi[3]);
      *(u32x2*)(HI + base + nt * 16 + (lane >> 4) * 4) = o;
    }
  }
}

template <int N2>
DI void unit_fft2(const Params& p, const SB& sb, int u, unsigned char* smem) {
  constexpr int N1 = N2;
  constexpr int LDH = N2 + 8;
  constexpr int MTW = N2 / 64;
  const u16* Z = (const u16*)(p.ws + OFF_Z);
  const u16* DFT = (const u16*)(p.ws + OFF_DFT);
  const u16* DC2 = (N2 == 128) ? DFT : DFT + 32768;
  const u16* DS2 = (N2 == 128) ? DFT + 16384 : DFT + 36864;
  const u16* HR = (const u16*)(p.ws + OFF_OUT);
  const u16* HI = HR + (size_t)MTOK * 512;
  u16* GATED = (u16*)(p.ws + OFF_GATED);
  u16* sHr = (u16*)smem;
  u16* sHi = sHr + 128 * 136;
  const int tid = TIDX(), lane = tid & 63, w = tid >> 6;
  const int g4 = u & 3; int t2 = u >> 2; const int k1 = t2 % N1, b = t2 / N1;
  const int L = sb.L;
  __syncthreads();
  for (int id = tid; id < N2 * 16; id += 256) {
    const int n2 = id % N2, ch = id / N2;
    const size_t src = (((size_t)b * N1 + k1) * N2 + n2) * 512 + g4 * 128 + ch * 8;
    const u32x4 a = *(const u32x4*)(HR + src);
    const u32x4 c = *(const u32x4*)(HI + src);
    const unsigned aw[4] = {a.x, a.y, a.z, a.w}, cw[4] = {c.x, c.y, c.z, c.w};
#pragma unroll
    for (int e = 0; e < 8; ++e) {
      sHr[(ch * 8 + e) * LDH + n2] = (u16)((e & 1) ? (aw[e >> 1] >> 16) : (aw[e >> 1] & 0xffff));
      sHi[(ch * 8 + e) * LDH + n2] = (u16)((e & 1) ? (cw[e >> 1] >> 16) : (cw[e >> 1] & 0xffff));
    }
  }
  __syncthreads();
  f32x4 acc[MTW][8];
#pragma unroll
  for (int a = 0; a < MTW; ++a)
#pragma unroll
    for (int c = 0; c < 8; ++c) acc[a][c] = f32x4{0.f, 0.f, 0.f, 0.f};
#pragma unroll
  for (int ks = 0; ks < N2 / 32; ++ks) {
    bf16x8 cf[MTW], sn[MTW];
#pragma unroll
    for (int mt = 0; mt < MTW; ++mt) {
      const int k2 = (w * MTW + mt) * 16 + (lane & 15);
      cf[mt] = ldfrag(DC2 + k2 * N2 + ks * 32 + (lane >> 4) * 8);
      sn[mt] = negfrag(ldfrag(DS2 + k2 * N2 + ks * 32 + (lane >> 4) * 8));
    }
#pragma unroll
    for (int nt = 0; nt < 8; ++nt) {
      const bf16x8 hr = ldfrag(sHr + (nt * 16 + (lane & 15)) * LDH + ks * 32 + (lane >> 4) * 8);
      const bf16x8 hi = ldfrag(sHi + (nt * 16 + (lane & 15)) * LDH + ks * 32 + (lane >> 4) * 8);
#pragma unroll
      for (int mt = 0; mt < MTW; ++mt) { acc[mt][nt] = mfma16(hr, cf[mt], acc[mt][nt]); acc[mt][nt] = mfma16(hi, sn[mt], acc[mt][nt]); }
    }
  }
  const float sc = rsqrtf((float)N2);
#pragma unroll
  for (int mt = 0; mt < MTW; ++mt) {
    const int k2 = (w * MTW + mt) * 16 + (lane & 15);
    const size_t row = (size_t)b * L + (size_t)k1 + (size_t)N1 * k2;
#pragma unroll
    for (int nt = 0; nt < 8; ++nt) {
      const int c = g4 * 128 + nt * 16 + (lane >> 4) * 4;
      const u32x2 gp = *(const u32x2*)(Z + row * LDZ + C_GP + 512 + c);
      u32x2 o;
      o.x = pack2(acc[mt][nt][0] * sc * siluf_(bflo(gp.x)), acc[mt][nt][1] * sc * siluf_(bfhi(gp.x)));
      o.y = pack2(acc[mt][nt][2] * sc * siluf_(bflo(gp.y)), acc[mt][nt][3] * sc * siluf_(bfhi(gp.y)));
      *(u32x2*)(GATED + row * LDG + 512 + c) = o;
    }
  }
}

DI void unit_attn_combine(const Params& p, int u) {
  const u16* Z = (const u16*)(p.ws + OFF_Z);
  const float* LSE = (const float*)(p.ws + OFF_LSE);
  u16* GATED = (u16*)(p.ws + OFF_GATED);
  const int tid = TIDX(), lane = tid & 63, w = tid >> 6;
#pragma unroll 1
  for (int rr = 0; rr < 4; ++rr) {
    const size_t row = (size_t)u * 16 + w * 4 + rr;
    const int c = lane * 8, h = c >> 7;
    const float l0 = LSE[row * 12 + h], l1 = LSE[row * 12 + 4 + h], l2 = LSE[row * 12 + 8 + h];
    const float mx = fmaxf(l0, fmaxf(l1, l2));
    const float e0 = __expf(l0 - mx), e1 = __expf(l1 - mx), e2 = __expf(l2 - mx);
    const float inv = 1.f / (e0 + e1 + e2);
    float o0[8], o1[8], o2[8], gp[8];
    unpack8(*(const u32x4*)(Z + row * LDZ + C_QA + c), o0);
    unpack8(*(const u32x4*)(Z + row * LDZ + C_QA + 512 + c), o1);
    unpack8(*(const u32x4*)(Z + row * LDZ + C_QA + 1024 + c), o2);
    unpack8(*(const u32x4*)(Z + row * LDZ + C_GP + c), gp);
    float y[8];
#pragma unroll
    for (int e = 0; e < 8; ++e) y[e] = (e0 * o0[e] + e1 * o1[e] + e2 * o2[e]) * inv * siluf_(gp[e]);
    u32x4 o; o.x = pack2(y[0], y[1]); o.y = pack2(y[2], y[3]); o.z = pack2(y[4], y[5]); o.w = pack2(y[6], y[7]);
    *(u32x4*)(GATED + row * LDG + c) = o;
    float dv[8], dg[8];
    unpack8(*(const u32x4*)(GATED + row * LDG + 1536 + c), dv);
    unpack8(*(const u32x4*)(Z + row * LDZ + C_GP + 3 * 512 + c), dg);
    u32x4 od; od.x = pack2(dv[0] * siluf_(dg[0]), dv[1] * siluf_(dg[1])); od.y = pack2(dv[2] * siluf_(dg[2]), dv[3] * siluf_(dg[3]));
    od.z = pack2(dv[4] * siluf_(dg[4]), dv[5] * siluf_(dg[5])); od.w = pack2(dv[6] * siluf_(dg[6]), dv[7] * siluf_(dg[7]));
    *(u32x4*)(GATED + row * LDG + 1536 + c) = od;
  }
}

DI void phase_branchproj(const Params& p, int l, unsigned char* smem_) {
  const u16* Z = (const u16*)(p.ws + OFF_Z);
  const u16* GATED = (const u16*)(p.ws + OFF_GATED);
  const u16* WbT = (const u16*)(p.ws + OFF_WB) + (size_t)l * DM * LDG;
  u16* MERGED = (u16*)(p.ws + OFF_H);
  u16* smem = (u16*)smem_;
  const int tid = TIDX(), lane = tid & 63, w = tid >> 6, wm = w >> 1, wn = w & 1;
  constexpr bool PIPE = false;
  u16* sA = smem;
  u16* sB = smem + 2 * 8192;
  const int lr = tid >> 3, lc = (tid & 7) * 8;
  const int wsw = ((tid & 7) ^ ((lr >> 1) & 7)) * 8;
  const int rg = (lane & 15) >> 1, rq = lane >> 4;
  const int rs0 = (((rg >> 2) * 4) + (rq ^ (rg & 3))) * 8;
  const int rs1 = ((((rg >> 2) ^ 1) * 4) + (rq ^ (rg & 3))) * 8;
  for (int u = VB(); u < 8 * 128; u += VG()) {
    const int nt0 = u / 128, mt0 = u % 128;
    const u16* A = GATED + (size_t)mt0 * 128 * LDG;
    const u16* Bt = WbT + (size_t)nt0 * 128 * LDG;
    const int lda = LDG, ldb = LDG;
    f32x4 mer[4][4], acc[4][4];
    zero_acc(mer);
    zero_acc(acc);
    u32x4 r0a[4], r0b[4];
    G_LOAD(r0a, r0b, 0)
    __syncthreads();
    G_WRITE(r0a, r0b, 0)
    __syncthreads();
#pragma unroll 1
    for (int kt = 0; kt < 32; ++kt) {
      const int buf = kt & 1, g = kt >> 3;
      if (kt + 1 < 32) { G_LOAD(r0a, r0b, (kt + 1) * 64) }
      G_COMPUTE(buf)
      if (kt + 1 < 32) { G_WRITE(r0a, r0b, buf ^ 1) }
      __syncthreads();
      if ((kt & 7) == 7) {
#pragma unroll
        for (int mt = 0; mt < 4; ++mt)
#pragma unroll
          for (int nt = 0; nt < 4; ++nt) {
            const int row = mt0 * 128 + wm * 64 + mt * 16 + (lane & 15);
            const int col = nt0 * 128 + wn * 64 + nt * 16 + (lane >> 4) * 4;
            const u32x2 mg = *(const u32x2*)(Z + (size_t)row * LDZ + C_MG + g * 1024 + col);
            mer[mt][nt][0] += sigmoidf_(bflo(mg.x)) * acc[mt][nt][0];
            mer[mt][nt][1] += sigmoidf_(bfhi(mg.x)) * acc[mt][nt][1];
            mer[mt][nt][2] += sigmoidf_(bflo(mg.y)) * acc[mt][nt][2];
            mer[mt][nt][3] += sigmoidf_(bfhi(mg.y)) * acc[mt][nt][3];
            acc[mt][nt] = f32x4{0.f, 0.f, 0.f, 0.f};
          }
      }
    }
#pragma unroll
    for (int mt = 0; mt < 4; ++mt)
#pragma unroll
      for (int nt = 0; nt < 4; ++nt) {
        const int row = mt0 * 128 + wm * 64 + mt * 16 + (lane & 15);
        const int col = nt0 * 128 + wn * 64 + nt * 16 + (lane >> 4) * 4;
        u32x2 o; o.x = pack2(mer[mt][nt][0], mer[mt][nt][1]); o.y = pack2(mer[mt][nt][2], mer[mt][nt][3]);
        *(u32x2*)(MERGED + (size_t)row * LDH + col) = o;
      }
  }
}

DI void phase_outproj(const Params& p, int l, unsigned char* smem_base) {
  pg8::Gemm g; g.A = (const u16*)(p.ws + OFF_H); g.Bt = (const u16*)(p.ws + OFF_WO) + (size_t)l * DM * LDH; g.M = MTOK; g.N = DM; g.K = DM; g.ld = LDH;
  pg8::StaticOrder S; S.init(MTOK, DM, gridDim.x, blockIdx.x);
  pg8::EpiBf16 E; E.O = (u16*)(p.ws + OFF_OUT); E.ldc = DM;
  pg8::gemm_phase((PG8_LAS unsigned char*)smem_base, g, S, E);
}

DI void mix1_unit(const Params& p, const Bucket& bk, const SB& sb, int l, unsigned char* smem, int dry, int u) {
  const int nF = sb.B * sb.N1 * 8;
  const int nC = (MTOK / 64) * 4;
  const int nD = (MTOK / 64) * 4;
  int v = u;
  if (v < nF) { if (!dry || (PROBE_UNITS & 1)) { if (sb.N1 == 128) unit_fft1<128>(p, sb, v, smem); else unit_fft1<64>(p, sb, v, smem); } return; }
  v -= nF;
  if (v < nC) { if (!dry || (PROBE_UNITS & 2)) unit_mlstm_local(p, sb, l, v, smem); return; }
  v -= nC;
  if (v < nD) { if (!dry || (PROBE_UNITS & 4)) unit_attnD(p, sb, l, v, smem); return; }
  v -= nD;
  if (!dry || (PROBE_UNITS & 8)) unit_attnA(p, bk, sb, v, smem, dry);
}
DI void phase_mix1(const Params& p, const Bucket& bk, const SB& sb, int l, unsigned char* smem, int dry, unsigned* qhead, volatile unsigned* qslot) {
  const int nF = sb.B * sb.N1 * 8;
  const int tot = MTOK * 12 / 64 + nF + 2 * (MTOK / 64) * 4;
  if (qhead == nullptr) {
    for (int u = VB(); u < tot; u += VG()) mix1_unit(p, bk, sb, l, smem, dry, u);
    return;
  }
  const int half = HALF_ID();
  if (threadIdx.x == 0) *qslot = xb_add(qhead, 1u);
  __syncthreads();
  for (;;) {
    const int k = (int)*qslot;
    if (2 * k >= tot) break;
    unsigned nxt = 0u;
    if (threadIdx.x == 0) nxt = xb_add(qhead, 1u);
    const int pos = 2 * k + half;
    const int u = (pos < tot - nF) ? pos + nF : pos - (tot - nF);
    mix1_unit(p, bk, sb, l, smem, dry, u);
    __syncthreads();
    if (threadIdx.x == 0) *qslot = nxt;
    __syncthreads();
  }
}
DI void mix2_unit(const Params& p, const SB& sb, unsigned char* smem, int dry, int u) {
  const int nS = sb.B * 8 * 32, nA = MTOK / 16;
  int v = u;
  if (v < nS) { unit_mlstm_scan(p, sb, v, smem, dry); return; }
  v -= nS;
  if (v < nA) { unit_attn_combine(p, v); return; }
  v -= nA;
  if (sb.N1 == 128) unit_fft2<128>(p, sb, v, smem); else unit_fft2<64>(p, sb, v, smem);
}
DI void phase_mix2(const Params& p, const SB& sb, int l, unsigned char* smem, int dry, unsigned* qhead, volatile unsigned* qslot) {
  const int nF = sb.B * sb.N1 * 4;
  const int nS = sb.B * 8 * 32;
  const int nA = MTOK / 16;
  const int tot = nF + nS + nA;
  if (qhead == nullptr) {
    for (int u = VB(); u < tot; u += VG()) mix2_unit(p, sb, smem, dry, u);
    return;
  }
  const int half = HALF_ID();
  if (threadIdx.x == 0) *qslot = xb_add(qhead, 1u);
  __syncthreads();
  for (;;) {
    const int k = (int)*qslot;
    if (2 * k >= tot) break;
    unsigned nxt = 0u;
    if (threadIdx.x == 0) nxt = xb_add(qhead, 1u);
    const int pos = 2 * k + half;
    const int u = (pos < nS) ? pos : (pos < nS + nF ? pos + nA : pos - nF);
    mix2_unit(p, sb, smem, dry, u);
    __syncthreads();
    if (threadIdx.x == 0) *qslot = nxt;
    __syncthreads();
  }
}
DI void phase_mix3(const Params& p, const SB& sb, int l, unsigned char* smem) {
  const int nC = (MTOK / 64) * 4;
  for (int u = VB(); u < nC; u += VG()) unit_mlstm_out(p, sb, l, u, smem);
}

constexpr int STEPS_PER_SB = 4 * 7 + 1;
constexpr int N_STEPS = 2 + 3 * STEPS_PER_SB;

DI void run_step(const Params& p0, const Bucket& bk, int s, unsigned char* smem_base, int dry, bool coop, volatile unsigned* qslot) {
  Params p = p0;
  asm volatile("" : "+s"(p.ws));
  unsigned char* smem = smem_base + HALF_ID() * SMEM_HALF;
  if (s == 0) { phase_prep0(p, bk, smem); return; }
  int sbi, l, ph;
  if (coop) {
    if (s == 1) { phase_prep1(p, smem); const SB sb0 = get_sb(p, 0); phase_rows(p, sb0, 0, dry); return; }
    const int s2 = s - 2, r = s2 % 28; sbi = s2 / 28;
    if (r == 27) {
      const SB sbx = get_sb(p, sbi); phase_rows(p, sbx, 4, dry);
      if (sbi < 2) { const SB sbn = get_sb(p, sbi + 1); phase_rows(p, sbn, 0, dry); }
      return;
    }
    if (r < 6) { l = 0; ph = r + 1; } else { const int q = r - 6; l = 1 + q / 7; ph = q % 7; }
  } else {
    if (s == 1) { phase_prep1(p, smem); return; }
    const int s2 = s - 2, r = s2 % STEPS_PER_SB; sbi = s2 / STEPS_PER_SB;
    if (r == 28) { const SB sbx = get_sb(p, sbi); phase_rows(p, sbx, 4, dry); return; }
    l = r / 7; ph = r % 7;
  }
  const SB sb = get_sb(p, sbi);
  switch (ph) {
    case 0: phase_rows(p, sb, l, dry); break;
    case 1: phase_inproj(p, l, smem_base); break;
    case 2: phase_mix1(p, bk, sb, l, smem, dry, coop ? (unsigned*)(p.ws + OFF_BAR) + 4096 + (s & 127) : nullptr, qslot); break;
    case 3: phase_mix2(p, sb, l, smem, dry, coop ? (unsigned*)(p.ws + OFF_BAR) + 4096 + (s & 127) : nullptr, qslot); break;
    case 4: phase_mix3(p, sb, l, smem); break;
    case 5: phase_branchproj(p, l, smem); break;
    default: phase_outproj(p, l, smem_base); break;
  }
}

__global__ void __launch_bounds__(512, 2) mega_step(Params p, Bucket bk, int s, int dry) {
  extern __shared__ __attribute__((aligned(16))) unsigned char smem[];
  run_step(p, bk, s, smem, dry, false, nullptr);
}

__global__ void __launch_bounds__(512, 2) mega_coop(Params p, Bucket bk) {
  extern __shared__ __attribute__((aligned(16))) unsigned char smem[];
  __shared__ uint4 xb_words;
  cg::grid_group grid = cg::this_grid();
  if (p.ws == nullptr) grid.sync();
  if (threadIdx.x == 0) xb_words = make_uint4(0u, 0u, 0u, 0u);
  __syncthreads();
  (void)xcd_barrier_post((unsigned*)(p.ws + OFF_BAR), (volatile LAS unsigned*)&xb_words);
  constexpr int N_STEPS_COOP = 2 + 3 * 28;
#pragma unroll 1
  for (int s = 0; s < N_STEPS_COOP; ++s) {
    run_step(p, bk, s, smem, 0, true, (volatile unsigned*)&xb_words + 2);
    if (s + 1 < N_STEPS_COOP) {
      XcdBarrier xb; xb.bar = (unsigned*)(p.ws + OFF_BAR); xb.x = xb_xcc_id(); xb.st = (volatile LAS unsigned*)&xb_words;
      xcd_barrier(xb);
    }
  }
}

static int t5_bucket_host(int rel) {
  const int nb = 16, max_exact = 8;
  int ret = (rel > 0) ? nb : 0;
  int n = rel < 0 ? -rel : rel;
  int nn = n > 1 ? n : 1;
  int large = max_exact + (int)(std::log((double)nn / max_exact) / std::log(1024.0 / max_exact) * (nb - max_exact));
  if (large > nb - 1) large = nb - 1;
  return ret + (n < max_exact ? n : large);
}

extern "C" void kernel_launch(void* const* d_in, const int* in_sizes, int n_in, void* d_out, int out_size, void* d_ws,
                              size_t ws_size, hipStream_t stream) {
  Params p;
  memset(&p, 0, sizeof(p));
  p.x_prompt = (const float*)d_in[0]; p.x_sample = (const float*)d_in[1];
  p.mem_prompt = (const float*)d_in[2]; p.mem_sample = (const float*)d_in[3];
  p.rel_bias = (const float*)d_in[4]; p.norm_pre = (const float*)d_in[5]; p.w_in = (const float*)d_in[6];
  p.conv_qk = (const float*)d_in[7]; p.gate_bias = (const float*)d_in[8]; p.head_gain = (const float*)d_in[9];
  p.mem_norm = (const float*)d_in[10]; p.w_mem_kv = (const float*)d_in[11]; p.w_branch = (const float*)d_in[12];
  p.w_out = (const float*)d_in[13]; p.norm_post = (const float*)d_in[14];
  p.out = (float*)d_out;
  p.ws = (unsigned char*)d_ws;
  Bucket bk;
  memset(&bk, 0, sizeof(bk));
  const int dil[3] = {1, 4, 16};
  for (int g = 0; g < 3; ++g)
    for (int i = 0; i < 129; ++i) bk.b[g][i] = (unsigned char)t5_bucket_host(dil[g] * (i - 64));
  if (ws_size < WS_NEED) fprintf(stderr, "workspace too small: %zu < %zu\n", ws_size, (size_t)WS_NEED);

  static int grid_blocks = 0;
  if (!grid_blocks) {
    int dev = 0, cus = 0, per_cu = 0;
    hipGetDevice(&dev);
    hipDeviceGetAttribute(&cus, hipDeviceAttributeMultiprocessorCount, dev);
    hipFuncSetAttribute((const void*)mega_step, hipFuncAttributeMaxDynamicSharedMemorySize, SMEM_BYTES);
    hipFuncSetAttribute((const void*)mega_coop, hipFuncAttributeMaxDynamicSharedMemorySize, SMEM_BYTES);
    hipOccupancyMaxActiveBlocksPerMultiprocessor(&per_cu, mega_coop, 512, SMEM_BYTES);
    if (per_cu < 1) per_cu = 1;
    if (per_cu > 1) per_cu = 1;
    grid_blocks = cus * per_cu;
  }
#if MK_COOP
  hipMemsetAsync((unsigned char*)d_ws + OFF_BAR, 0, (4096 + 128) * sizeof(unsigned), stream);
  void* args[] = {&p, &bk};
  hipError_t e = hipLaunchCooperativeKernel((void*)mega_coop, dim3(grid_blocks), dim3(512), args, SMEM_BYTES, stream);
  if (e != hipSuccess) fprintf(stderr, "cooperative launch failed: %s (grid %d)\n", hipGetErrorString(e), grid_blocks);
#else
  for (int s = 0; s < N_STEPS; ++s) {
    if (PROBE_REPEAT > 0 && s >= 2 && ((s - 2) % STEPS_PER_SB) != 28 && ((PROBE_REPEAT >> (((s - 2) % STEPS_PER_SB) % 7)) & 1))
      hipLaunchKernelGGL(mega_step, dim3(grid_blocks), dim3(512), SMEM_BYTES, stream, p, bk, s, 1);
    hipLaunchKernelGGL(mega_step, dim3(grid_blocks), dim3(512), SMEM_BYTES, stream, p, bk, s, 0);
  }
#endif
}
```

```cpp
#include <hip/hip_runtime.h>
#include <hip/hip_cooperative_groups.h>
#include <cstdio>
#include <cstring>
#include <cmath>
namespace cg = cooperative_groups;

#ifndef MK_COOP
#define MK_COOP 1
#endif
#ifndef PROBE_UNITS
#define PROBE_UNITS 15
#endif
#ifndef PROBE_REPEAT
#define PROBE_REPEAT 0
#endif

typedef unsigned short u16;
using bf16x8 = __attribute__((ext_vector_type(8))) short;
using s16x4 = __attribute__((ext_vector_type(4))) short;
using f32x4 = __attribute__((ext_vector_type(4))) float;
using u32x4 = __attribute__((ext_vector_type(4))) unsigned;
using u32x2 = __attribute__((ext_vector_type(2))) unsigned;
#define DI __device__ __forceinline__

constexpr int DM = 1024;
constexpr int LDZ = 14080;
constexpr int NORIG = 13840;
constexpr int C_QA = 0, C_KA = 1536, C_VA = 3072, C_XB = 4608, C_QC = 5120, C_KC = 5632, C_VC = 6144, C_OC = 6656,
              C_QD = 7168, C_GP = 7680, C_MG = 9728, C_GC = 13824;
constexpr int LDH = 1088;
constexpr int LDG = 2112;
constexpr int MTOK = 16384;
constexpr float EPSV = 1e-6f;
constexpr float QSCALE = 0.08838834764831845f;
constexpr int SMEM_HALF = 75776;
constexpr int SMEM_BYTES = 2 * SMEM_HALF;

constexpr size_t OFF_WIN = 0;
constexpr size_t OFF_WB = OFF_WIN + (size_t)4 * LDZ * LDH * 2;
constexpr size_t OFF_WO = OFF_WB + (size_t)4 * 1024 * LDG * 2;
constexpr size_t OFF_KVK = OFF_WO + (size_t)4 * 1024 * LDH * 2;
constexpr size_t OFF_KVV = OFF_KVK + 6291456;
constexpr size_t OFF_DFT = OFF_KVV + 6291456;
constexpr size_t OFF_H = OFF_DFT + 131072;
constexpr size_t OFF_GATED = OFF_H + (size_t)16384 * LDH * 2;
constexpr size_t OFF_LSE = OFF_GATED + (size_t)16384 * LDG * 2;
constexpr size_t OFF_OUT = OFF_LSE + 786432;
constexpr size_t OFF_CS = OFF_OUT + 67108864;
constexpr size_t OFF_NS = OFF_CS + 67108864;
constexpr size_t OFF_SC = OFF_NS + 1048576;
constexpr size_t OFF_BAR = OFF_SC + 32768;
constexpr size_t OFF_Z = OFF_SC + 65536;
constexpr size_t OFF_WKV = OFF_Z;
constexpr size_t OFF_HM = OFF_Z + (size_t)4 * 1024 * LDH * 2;
constexpr size_t WS_NEED = OFF_Z + (size_t)16384 * LDZ * 2;

struct Params {
  const float *x_prompt, *x_sample, *mem_prompt, *mem_sample, *rel_bias, *norm_pre, *w_in, *conv_qk, *gate_bias,
      *head_gain, *mem_norm, *w_mem_kv, *w_branch, *w_out, *norm_post;
  float* out;
  unsigned char* ws;
};
struct Bucket { unsigned char b[3][136]; };

DI int TIDX() { int t = threadIdx.x & 255; asm volatile("" : "+v"(t)); return t; }
DI int HALF_ID() { return __builtin_amdgcn_readfirstlane((int)(threadIdx.x >> 8)); }
DI int VB() { return (int)blockIdx.x * 2 + HALF_ID(); }
DI int VG() { return (int)gridDim.x * 2; }
typedef __bf16 bf16x2_t __attribute__((ext_vector_type(2)));
typedef float f32x2_t __attribute__((ext_vector_type(2)));
DI unsigned cvt_pk_bf16_hw(float lo, float hi) { const f32x2_t v = {lo, hi}; return __builtin_bit_cast(unsigned, __builtin_convertvector(v, bf16x2_t)); }
DI u16 f2bf(float x) { return (u16)(cvt_pk_bf16_hw(x, x) & 0xffffu); }
DI float bf2f(u16 h) { return __uint_as_float(((unsigned)h) << 16); }
DI float bflo(unsigned u) { return __uint_as_float(u << 16); }
DI float bfhi(unsigned u) { return __uint_as_float(u & 0xffff0000u); }
DI unsigned pack2(float a, float b) { return cvt_pk_bf16_hw(a, b); }
DI f32x4 mfma16(bf16x8 a, bf16x8 b, f32x4 c) { return __builtin_amdgcn_mfma_f32_16x16x32_bf16(a, b, c, 0, 0, 0); }
DI bf16x8 ldfrag(const u16* p) { return *reinterpret_cast<const bf16x8*>(p); }
DI float wsum(float v) { for (int o = 32; o; o >>= 1) v += __shfl_xor(v, o); return v; }
DI float wmaxr(float v) { for (int o = 32; o; o >>= 1) v = fmaxf(v, __shfl_xor(v, o)); return v; }
DI float sigmoidf_(float x) { return __builtin_amdgcn_rcpf(1.f + __expf(-x)); }
DI float siluf_(float x) { return x * __builtin_amdgcn_rcpf(1.f + __expf(-x)); }
DI float logsigf_(float x) { return fminf(x, 0.f) - log1pf(__expf(-fabsf(x))); }
DI void unpack8(u32x4 v, float (&f)[8]) {
  f[0] = bflo(v.x); f[1] = bfhi(v.x); f[2] = bflo(v.y); f[3] = bfhi(v.y);
  f[4] = bflo(v.z); f[5] = bfhi(v.z); f[6] = bflo(v.w); f[7] = bfhi(v.w);
}
DI bf16x8 negfrag(bf16x8 a) {
  bf16x8 r;
#pragma unroll
  for (int j = 0; j < 8; ++j) r[j] = (short)(a[j] ^ (short)0x8000);
  return r;
}


#define XB_TMO      128
#define XB_XCNT(j)  (256  + 64 * (j))
#define XB_XSUB(j)  (1280 + 64 * (j))
#define XB_XGEN(j)  (2304 + 64 * (j))
#define XB_TOP      3328
#define XB_TOPGEN   3392
#define XCD_BAR_WORDS 3456
#define XB_SPIN_CAP (1u << 22)
#define LAS __attribute__((address_space(3)))
DI unsigned xb_ld(unsigned* p) { return __hip_atomic_load(p, __ATOMIC_RELAXED, __HIP_MEMORY_SCOPE_AGENT); }
DI unsigned xb_add(unsigned* p, unsigned v) { return __hip_atomic_fetch_add(p, v, __ATOMIC_RELAXED, __HIP_MEMORY_SCOPE_AGENT); }
DI unsigned xb_xcc_id() { return (unsigned)__builtin_amdgcn_s_getreg((3 << 11) | 20) & 0xFu; }
#define XB_SPIN(cond, bar) do { unsigned _sp = 0; while (cond) { __builtin_amdgcn_s_sleep(1); \
    if ((++_sp & 255u) == 0u) { if (xb_ld(&(bar)[XB_TMO])) break; if (_sp > XB_SPIN_CAP) { atomicAdd(&(bar)[XB_TMO], 1u); break; } } } } while (0)
struct XcdBarrier { unsigned* bar; unsigned x; volatile LAS unsigned* st; };
DI XcdBarrier xcd_barrier_post(unsigned* bar, volatile LAS unsigned* st) {
  XcdBarrier b; b.bar = bar; b.x = xb_xcc_id(); b.st = st;
  if (threadIdx.x == 0) (void)xb_add(&bar[XB_XCNT(b.x)], 1u);
  return b;
}
DI void xcd_barrier_complete(unsigned* bar, unsigned x, unsigned& nloc, unsigned& nx) {
  const unsigned G = gridDim.x * gridDim.y * gridDim.z;
  unsigned sum, cnt, mine, sp = 0u;
  for (;;) {
    sum = 0u; cnt = 0u; mine = 0u;
#pragma unroll
    for (unsigned j = 0; j < 16; ++j) { const unsigned c = xb_ld(&bar[XB_XCNT(j)]); sum += c; cnt += (c > 0u) ? 1u : 0u; mine = (j == x) ? c : mine; }
    if (sum == G) break;
    __builtin_amdgcn_s_sleep(1);
    if ((++sp & 255u) == 0u) { if (xb_ld(&bar[XB_TMO])) break; if (sp > XB_SPIN_CAP) { atomicAdd(&bar[XB_TMO], 1u); break; } }
  }
  nloc = mine > 0u ? mine : 1u; nx = cnt > 0u ? cnt : 1u;
}
DI void xcd_barrier(const XcdBarrier& b) {
  asm volatile("s_waitcnt vmcnt(0)" ::: "memory");
  __syncthreads();
  if (threadIdx.x == 0) {
    unsigned* bar = b.bar;
    __builtin_amdgcn_s_waitcnt(0);
    unsigned nloc = b.st[0], nx = b.st[1];
    if (nloc == 0u) { xcd_barrier_complete(bar, b.x, nloc, nx); b.st[0] = nloc; b.st[1] = nx; }
    const unsigned old = xb_add(&bar[XB_XSUB(b.x)], 1u);
    const unsigned gen = old / nloc;
    if (old + 1u == (gen + 1u) * nloc) {
      __builtin_amdgcn_fence(__ATOMIC_RELEASE, "agent");
      asm volatile("s_waitcnt vmcnt(0)" ::: "memory");
      const unsigned og = xb_add(&bar[XB_TOP], 1u);
      const unsigned tg = og / nx;
      if (og + 1u == (tg + 1u) * nx) xb_add(&bar[XB_TOPGEN], 1u);
      else XB_SPIN(xb_ld(&bar[XB_TOPGEN]) == tg, bar);
      __builtin_amdgcn_fence(__ATOMIC_ACQUIRE, "agent");
      xb_add(&bar[XB_XGEN(b.x)], 1u);
      asm volatile("s_waitcnt vmcnt(0)" ::: "memory");
    } else {
      XB_SPIN(xb_ld(&bar[XB_XGEN(b.x)]) == gen, bar);
      __builtin_amdgcn_fence(__ATOMIC_ACQUIRE, "agent");
      asm volatile("s_waitcnt vmcnt(0)" ::: "memory");
    }
  }
  __syncthreads();
}

struct SB {
  const float* xin; float* xout; int B, L, memb, N1;
};
DI SB get_sb(const Params& p, int sb) {
  SB s;
  if (sb < 2) { s.xin = p.x_sample + (size_t)sb * MTOK * DM; s.xout = p.out + (size_t)(MTOK + sb * MTOK) * DM; s.B = 1; s.L = 16384; s.memb = 4 + sb; s.N1 = 128; }
  else { s.xin = p.x_prompt; s.xout = p.out; s.B = 4; s.L = 4096; s.memb = 0; s.N1 = 64; }
  return s;
}

#define G_LOAD(RA, RB, K0) _Pragma("unroll") for (int i = 0; i < 4; ++i) { \
    RA[i] = *(const u32x4*)(A + (size_t)(lr + 32 * i) * lda + (K0) + lc); RB[i] = *(const u32x4*)(Bt + (size_t)(lr + 32 * i) * ldb + (K0) + lc); }
#define G_WRITE(RA, RB, BUF) _Pragma("unroll") for (int i = 0; i < 4; ++i) { \
    *(u32x4*)(sA + (BUF) * 8192 + (lr + 32 * i) * 64 + wsw) = RA[i]; *(u32x4*)(sB + (BUF) * 8192 + (lr + 32 * i) * 64 + wsw) = RB[i]; }
#define G_COMPUTE(BUF) { \
    const u16* a0 = sA + (BUF) * 8192 + (wm * 64 + (lane & 15)) * 64; \
    const u16* b0 = sB + (BUF) * 8192 + (wn * 64 + (lane & 15)) * 64; \
    if (PIPE) { \
      bf16x8 a[2][4], b[2][4]; \
      _Pragma("unroll") for (int t = 0; t < 4; ++t) { a[0][t] = ldfrag(a0 + t * 1024 + rs0); b[0][t] = ldfrag(b0 + t * 1024 + rs0); } \
      _Pragma("unroll") for (int t = 0; t < 4; ++t) { a[1][t] = ldfrag(a0 + t * 1024 + rs1); b[1][t] = ldfrag(b0 + t * 1024 + rs1); } \
      __builtin_amdgcn_sched_barrier(0); \
      _Pragma("unroll") for (int ks = 0; ks < 2; ++ks) \
        _Pragma("unroll") for (int mt = 0; mt < 4; ++mt) _Pragma("unroll") for (int nt = 0; nt < 4; ++nt) acc[mt][nt] = mfma16(b[ks][nt], a[ks][mt], acc[mt][nt]); \
      __builtin_amdgcn_sched_barrier(0); \
    } else { \
      _Pragma("unroll") for (int ks = 0; ks < 2; ++ks) { \
        bf16x8 a[4], b[4]; \
        _Pragma("unroll") for (int t = 0; t < 4; ++t) { a[t] = ldfrag(a0 + t * 1024 + (ks ? rs1 : rs0)); b[t] = ldfrag(b0 + t * 1024 + (ks ? rs1 : rs0)); } \
        _Pragma("unroll") for (int mt = 0; mt < 4; ++mt) _Pragma("unroll") for (int nt = 0; nt < 4; ++nt) acc[mt][nt] = mfma16(b[nt], a[mt], acc[mt][nt]); } } }
template <bool DEEP, bool PIPE>
DI void gemm_acc(f32x4 (&acc)[4][4], const u16* __restrict__ A, int lda, const u16* __restrict__ Bt, int ldb, int nk, u16* smem) {
  const int tid = TIDX(), lane = tid & 63, w = tid >> 6, wm = w >> 1, wn = w & 1;
  u16* sA = smem;
  u16* sB = smem + 2 * 8192;
  const int lr = tid >> 3, lc = (tid & 7) * 8;
  const int wsw = ((tid & 7) ^ ((lr >> 1) & 7)) * 8;
  const int rg = (lane & 15) >> 1, rq = lane >> 4;
  const int rs0 = (((rg >> 2) * 4) + (rq ^ (rg & 3))) * 8;
  const int rs1 = ((((rg >> 2) ^ 1) * 4) + (rq ^ (rg & 3))) * 8;
  u32x4 r0a[4], r0b[4];
  G_LOAD(r0a, r0b, 0)
  if (DEEP) {
    u32x4 r1a[4], r1b[4];
    G_LOAD(r1a, r1b, 64)
    __syncthreads();
    G_WRITE(r0a, r0b, 0)
    __syncthreads();
    if (2 < nk) { G_LOAD(r0a, r0b, 128) }
#pragma unroll 1
    for (int kt = 0; kt < nk; kt += 2) {
      G_COMPUTE(0)
      if (kt + 1 < nk) { G_WRITE(r1a, r1b, 1) }
      if (kt + 3 < nk) { G_LOAD(r1a, r1b, (kt + 3) * 64) }
      __syncthreads();
      if (kt + 1 >= nk) break;
      G_COMPUTE(1)
      if (kt + 2 < nk) { G_WRITE(r0a, r0b, 0) }
      if (kt + 4 < nk) { G_LOAD(r0a, r0b, (kt + 4) * 64) }
      __syncthreads();
    }
  } else {
    __syncthreads();
    G_WRITE(r0a, r0b, 0)
    __syncthreads();
#pragma unroll 1
    for (int kt = 0; kt < nk; ++kt) {
      const int buf = kt & 1;
      if (kt + 1 < nk) { G_LOAD(r0a, r0b, (kt + 1) * 64) }
      G_COMPUTE(buf)
      if (kt + 1 < nk) { G_WRITE(r0a, r0b, buf ^ 1) }
      __syncthreads();
    }
  }
}

#define G_READ(F_A, F_B, BUF, RS) { \
    const u16* a0 = sA + (BUF) * 8192 + (wm * 64 + (lane & 15)) * 64 + (RS); \
    const u16* b0 = sB + (BUF) * 8192 + (wn * 64 + (lane & 15)) * 64 + (RS); \
    _Pragma("unroll") for (int t = 0; t < 4; ++t) { F_A[t] = ldfrag(a0 + t * 1024); F_B[t] = ldfrag(b0 + t * 1024); } }
#define G_MMA(F_A, F_B) { \
    _Pragma("unroll") for (int mt = 0; mt < 4; ++mt) _Pragma("unroll") for (int nt = 0; nt < 4; ++nt) acc[mt][nt] = mfma16(F_B[nt], F_A[mt], acc[mt][nt]); }
DI void gemm_acc_sp(f32x4 (&acc)[4][4], const u16* __restrict__ A, int lda, const u16* __restrict__ Bt, int ldb, int nk, u16* smem) {
  const int tid = TIDX(), lane = tid & 63, w = tid >> 6, wm = w >> 1, wn = w & 1;
  u16* sA = smem;
  u16* sB = smem + 2 * 8192;
  const int lr = tid >> 3, lc = (tid & 7) * 8;
  const int wsw = ((tid & 7) ^ ((lr >> 1) & 7)) * 8;
  const int rg = (lane & 15) >> 1, rq = lane >> 4;
  const int rs0 = (((rg >> 2) * 4) + (rq ^ (rg & 3))) * 8;
  const int rs1 = ((((rg >> 2) ^ 1) * 4) + (rq ^ (rg & 3))) * 8;
  u32x4 r0a[4], r0b[4];
  bf16x8 fa0[4], fb0[4], fa1[4], fb1[4];
  G_LOAD(r0a, r0b, 0)
  __syncthreads();
  G_WRITE(r0a, r0b, 0)
  __syncthreads();
  if (1 < nk) { G_LOAD(r0a, r0b, 64) }
  G_READ(fa0, fb0, 0, rs0)
#pragma unroll 1
  for (int kt = 0; kt < nk; ++kt) {
    const int buf = kt & 1;
    G_READ(fa1, fb1, buf, rs1)
    __builtin_amdgcn_sched_barrier(0);
    G_MMA(fa0, fb0)
    __builtin_amdgcn_sched_barrier(0);
    if (kt + 1 < nk) { G_WRITE(r0a, r0b, buf ^ 1) }
    if (kt + 2 < nk) { G_LOAD(r0a, r0b, (kt + 2) * 64) }
    __syncthreads();
    if (kt + 1 < nk) { G_READ(fa0, fb0, buf ^ 1, rs0) }
    __builtin_amdgcn_sched_barrier(0);
    G_MMA(fa1, fb1)
    __builtin_amdgcn_sched_barrier(0);
  }
}
DI void zero_acc(f32x4 (&acc)[4][4]) {
#pragma unroll
  for (int a = 0; a < 4; ++a)
#pragma unroll
    for (int b = 0; b < 4; ++b) acc[a][b] = f32x4{0.f, 0.f, 0.f, 0.f};
}

DI int win_orig_col(int n) { return n < 7168 ? n : (n < 13824 ? n + 16 : (n < 13840 ? n - 13824 + 7168 : -1)); }

template <bool WINMAP>
DI void transpose_tile(const float* __restrict__ src, size_t src_ld, u16* __restrict__ dst, size_t dst_ld, int r0, int c0, float* sT) {
  const int tid = TIDX();
  __syncthreads();
#pragma unroll 4
  for (int i = 0; i < 16; ++i) {
    const int r = i * 4 + (tid >> 6), c = tid & 63;
    int sc = c0 + c;
    if (WINMAP) sc = win_orig_col(sc);
    sT[r * 65 + c] = (sc >= 0) ? src[(size_t)(r0 + r) * src_ld + sc] : 0.f;
  }
  __syncthreads();
#pragma unroll 4
  for (int i = 0; i < 16; ++i) {
    const int c = i * 4 + (tid >> 6), r = tid & 63;
    dst[(size_t)(c0 + c) * dst_ld + r0 + r] = f2bf(sT[r * 65 + c]);
  }
}

DI void phase_prep0(const Params& p, const Bucket& bk, unsigned char* smem) {
  float* sT = (float*)smem;
  u16* WinT = (u16*)(p.ws + OFF_WIN);
  u16* WbT = (u16*)(p.ws + OFF_WB);
  u16* WoT = (u16*)(p.ws + OFF_WO);
  u16* WkvT = (u16*)(p.ws + OFF_WKV);
  u16* HM = (u16*)(p.ws + OFF_HM);
  u16* DFT = (u16*)(p.ws + OFF_DFT);
  constexpr int U_WIN = 4 * 220 * 16, U_WB = 4 * 4 * 8 * 16, U_WO = 4 * 16 * 16, U_WKV = 4 * 16 * 16, U_HM = 1536, U_DFT = 160, U_BT = 8;
  constexpr int TOT = U_WIN + U_WB + U_WO + U_WKV + U_HM + U_DFT + U_BT;
  const int tid = TIDX(), lane = tid & 63, w = tid >> 6;
  for (int u = VB(); u < TOT; u += VG()) {
    int v = u;
    if (v < U_WIN) {
      const int l = v / (220 * 16), r = v % (220 * 16), nt = r / 16, kt = r % 16;
      transpose_tile<true>(p.w_in + (size_t)l * DM * NORIG, NORIG, WinT + (size_t)l * LDZ * LDH, LDH, kt * 64, nt * 64, sT);
      continue;
    }
    v -= U_WIN;
    if (v < U_WB) {
      const int l = v / 512, r = v % 512, g = r / 128, r2 = r % 128, ct = r2 / 16, dt = r2 % 16;
      transpose_tile<false>(p.w_branch + ((size_t)(l * 4 + g) * 512) * DM, DM, WbT + (size_t)l * DM * LDG + g * 512, LDG, ct * 64, dt * 64, sT);
      continue;
    }
    v -= U_WB;
    if (v < U_WO) {
      const int l = v / 256, r = v % 256, kt = r / 16, nt = r % 16;
      transpose_tile<false>(p.w_out + (size_t)l * DM * DM, DM, WoT + (size_t)l * DM * LDH, LDH, kt * 64, nt * 64, sT);
      continue;
    }
    v -= U_WO;
    if (v < U_WKV) {
      const int l = v / 256, r = v % 256, kt = r / 16, nt = r % 16;
      transpose_tile<false>(p.w_mem_kv + (size_t)l * DM * DM, DM, WkvT + (size_t)l * DM * LDH, LDH, kt * 64, nt * 64, sT);
      continue;
    }
    v -= U_WKV;
    if (v < U_HM) {
      const int row = v;
      if (w == 0) {
        const float* src = (row < 1024) ? p.mem_prompt + (size_t)row * DM : p.mem_sample + (size_t)(row - 1024) * DM;
        float4 xv[4];
        float ss = 0.f;
#pragma unroll
        for (int i = 0; i < 4; ++i) { xv[i] = *(const float4*)(src + (i * 64 + lane) * 4); ss += xv[i].x * xv[i].x + xv[i].y * xv[i].y + xv[i].z * xv[i].z + xv[i].w * xv[i].w; }
        ss = wsum(ss);
        const float rstd = rsqrtf(ss * (1.f / DM) + EPSV);
        for (int l = 0; l < 4; ++l) {
#pragma unroll
          for (int i = 0; i < 4; ++i) {
            const float4 g = *(const float4*)(p.mem_norm + l * DM + (i * 64 + lane) * 4);
            u32x2 o; o.x = pack2(xv[i].x * rstd * g.x, xv[i].y * rstd * g.y); o.y = pack2(xv[i].z * rstd * g.z, xv[i].w * rstd * g.w);
            *(u32x2*)(HM + ((size_t)l * 1536 + row) * LDH + (i * 64 + lane) * 4) = o;
          }
        }
      }
      continue;
    }
    v -= U_HM;
    if (v >= U_DFT) {
      const int e = (v - U_DFT) * 256 + tid;
      if (e < 3 * 4 * 129) {
        const int gh = e / 129, i = e % 129, g = gh >> 2;
        ((float*)(p.ws + OFF_DFT + 98304))[e] = p.rel_bias[(int)bk.b[g][i] * 12 + gh];
      }
      continue;
    }
    {
      const int e = v * 256 + tid;
      if (e < 40960) {
        int N, idx, isS;
        if (e < 32768) { N = 128; isS = e >= 16384; idx = e & 16383; }
        else { N = 64; isS = (e - 32768) >= 4096; idx = (e - 32768) & 4095; }
        const int i = idx / N, j = idx % N;
        const float a = 2.f * (float)((i * j) % N) / (float)N;
        DFT[e] = f2bf(isS ? sinpif(a) : cospif(a));
      }
    }
  }
}

DI void phase_prep1(const Params& p, unsigned char* smem) {
  const u16* WkvT = (const u16*)(p.ws + OFF_WKV);
  const u16* HM = (const u16*)(p.ws + OFF_HM);
  u16* KVK = (u16*)(p.ws + OFF_KVK);
  u16* KVV = (u16*)(p.ws + OFF_KVV);
  const int tid = TIDX(), lane = tid & 63, w = tid >> 6, wm = w >> 1, wn = w & 1;
  for (int u = VB(); u < 4 * 12 * 8; u += VG()) {
    const int l = u / 96, r = u % 96, mt0 = r / 8, nt0 = r % 8;
    f32x4 acc[4][4];
    zero_acc(acc);
    gemm_acc<false, true>(acc, HM + ((size_t)l * 1536 + mt0 * 128) * LDH, LDH, WkvT + ((size_t)l * DM + nt0 * 128) * LDH, LDH, 16, (u16*)smem);
#pragma unroll
    for (int mt = 0; mt < 4; ++mt)
#pragma unroll
      for (int nt = 0; nt < 4; ++nt)
#pragma unroll
        for (int i = 0; i < 4; ++i) {
          const int row = mt0 * 128 + wm * 64 + mt * 16 + (lane & 15);
          const int col = nt0 * 128 + wn * 64 + nt * 16 + (lane >> 4) * 4 + i;
          const int b = row >> 8, m = row & 255;
          const int sel = col >> 9, h = (col >> 7) & 3, c = col & 127;
          const u16 val = f2bf(acc[mt][nt][i]);
          const size_t base = ((size_t)(l * 6 + b) * 4 + h) * 256 * 128;
          if (sel == 0) KVK[base + m * 128 + c] = val;
          else KVV[base + c * 256 + m] = val;
        }
  }
}

DI void phase_rows(const Params& p, const SB& sb, int l, int dry) {
  const u16* OUTB = (const u16*)(p.ws + OFF_OUT);
  u16* H = (u16*)(p.ws + OFF_H);
  const int tid = TIDX(), lane = tid & 63, w = tid >> 6;
  for (int row = VB() * 4 + w; row < MTOK; row += VG() * 4) {
    float4 xv[4];
    if (l == 0) {
#pragma unroll
      for (int i = 0; i < 4; ++i) xv[i] = *(const float4*)(sb.xin + (size_t)row * DM + (i * 64 + lane) * 4);
    } else {
      const float* xp = (l == 1 ? sb.xin : sb.xout) + (size_t)row * DM;
      float4 ov[4];
      float ss = 0.f;
#pragma unroll
      for (int i = 0; i < 4; ++i) { const u32x2 ob = *(const u32x2*)(OUTB + (size_t)row * DM + (i * 64 + lane) * 4);
        ov[i].x = bflo(ob.x); ov[i].y = bfhi(ob.x); ov[i].z = bflo(ob.y); ov[i].w = bfhi(ob.y);
        ss += ov[i].x * ov[i].x + ov[i].y * ov[i].y + ov[i].z * ov[i].z + ov[i].w * ov[i].w; }
      ss = wsum(ss);
      const float rstd = rsqrtf(ss * (1.f / DM) + EPSV);
#pragma unroll
      for (int i = 0; i < 4; ++i) {
        const float4 g = *(const float4*)(p.norm_post + (l - 1) * DM + (i * 64 + lane) * 4);
        const float4 xo = *(const float4*)(xp + (i * 64 + lane) * 4);
        xv[i].x = xo.x + ov[i].x * rstd * g.x; xv[i].y = xo.y + ov[i].y * rstd * g.y;
        xv[i].z = xo.z + ov[i].z * rstd * g.z; xv[i].w = xo.w + ov[i].w * rstd * g.w;
        if (!dry) *(float4*)(sb.xout + (size_t)row * DM + (i * 64 + lane) * 4) = xv[i];
      }
    }
    if (l < 4) {
      float ss = 0.f;
#pragma unroll
      for (int i = 0; i < 4; ++i) ss += xv[i].x * xv[i].x + xv[i].y * xv[i].y + xv[i].z * xv[i].z + xv[i].w * xv[i].w;
      ss = wsum(ss);
      const float rstd = rsqrtf(ss * (1.f / DM) + EPSV);
#pragma unroll
      for (int i = 0; i < 4; ++i) {
        const float4 g = *(const float4*)(p.norm_pre + l * DM + (i * 64 + lane) * 4);
        u32x2 o; o.x = pack2(xv[i].x * rstd * g.x, xv[i].y * rstd * g.y); o.y = pack2(xv[i].z * rstd * g.z, xv[i].w * rstd * g.w);
        *(u32x2*)(H + (size_t)row * LDH + (i * 64 + lane) * 4) = o;
      }
    }
  }
}

namespace pg8 {
#define PG8_LAS __attribute__((address_space(3)))
constexpr int BM = 256, BK = 64, HALF = 128, HTB = HALF * BK * 2, STAGE_BYTES = 8 * HTB, NXCD = 8, WGM = 8;
DI int lds_byte(int r, int c) { const int st = (r >> 4) * 2 + (c >> 5), rr = r & 15, cc = c & 31, ob = rr * 64 + cc * 2; return st * 1024 + (ob ^ (((ob >> 9) & 1) << 5)); }
DI void stage_rc(int b, int& R, int& C) { const int st = b / 1024, sb = b % 1024, swz = sb ^ (((sb >> 9) & 1) << 5); R = (st >> 1) * 16 + swz / 64; C = (st & 1) * 32 + (swz % 64) / 2; }
DI int perm32(int rho) { const int n = rho >> 4, i = rho & 15; return 8 * (i >> 2) + 4 * n + (i & 3); }
struct Unit { int pm, pn; };
struct Gemm { const u16* A; const u16* Bt; int M, N, K, ld; };
struct StaticOrder {
  int nM, nN, nwg, G, c;
  DI void init(int M, int N, int G_, int c_) { nM = M / BM; nN = N / BM; nwg = nM * nN; G = G_; c = c_; }
  DI bool next(int i, Unit& u) const {
    const long L = (long)i * G + c; if (L >= nwg) return false;
    int wgid = (int)L; { const int q = nwg / NXCD, r = nwg % NXCD, xcd = wgid % NXCD, off = wgid / NXCD; wgid = (xcd < r ? xcd * (q + 1) : r * (q + 1) + (xcd - r) * q) + off; }
    const int nig = WGM * nN, gid = wgid / nig, fm = gid * WGM, gsz = (nM - fm) < WGM ? (nM - fm) : WGM;
    u.pm = fm + ((wgid % nig) % gsz); u.pn = (wgid % nig) / gsz; return true;
  }
};
DI unsigned cvt_pk_bf16(float lo, float hi) { unsigned r; asm volatile("v_cvt_pk_bf16_f32 %0, %1, %2" : "=v"(r) : "v"(lo), "v"(hi)); return r; }
struct EpiF32 {
  static constexpr bool PERM = false;
  float* C; int ldc;
  DI void operator()(const f32x4 (&acc)[2][2][4][2], const Unit& u, int wr, int wc, int fr, int fq) const {
    const int row0 = u.pm * BM + wr * 64 + fr, col0 = u.pn * BM + wc * 32 + 4 * fq;
#pragma unroll
    for (int ai = 0; ai < 2; ++ai)
#pragma unroll
      for (int m = 0; m < 4; ++m) { float* rowp = C + (size_t)(row0 + ai * HALF + m * 16) * ldc + col0;
#pragma unroll
        for (int bj = 0; bj < 2; ++bj)
#pragma unroll
          for (int n = 0; n < 2; ++n) *(f32x4*)(rowp + bj * HALF + n * 16) = acc[ai][bj][m][n]; }
  }
};
struct EpiBf16 {
  static constexpr bool PERM = true;
  u16* O; int ldc;
  DI void operator()(const f32x4 (&acc)[2][2][4][2], const Unit& u, int wr, int wc, int fr, int fq) const {
    const int row0 = u.pm * BM + wr * 64 + fr, col0 = u.pn * BM + wc * 32 + 8 * fq;
#pragma unroll
    for (int ai = 0; ai < 2; ++ai)
#pragma unroll
      for (int m = 0; m < 4; ++m) { u16* rowp = O + (size_t)(row0 + ai * HALF + m * 16) * ldc + col0;
#pragma unroll
        for (int bj = 0; bj < 2; ++bj) { const f32x4 v0 = acc[ai][bj][m][0], v1 = acc[ai][bj][m][1];
          u32x4 w; w.x = cvt_pk_bf16(v0[0], v0[1]); w.y = cvt_pk_bf16(v0[2], v0[3]); w.z = cvt_pk_bf16(v1[0], v1[1]); w.w = cvt_pk_bf16(v1[2], v1[3]);
          *(u32x4*)(rowp + bj * HALF) = w; } }
  }
};
template <class Epi, class Sched>
DI void gemm_phase(PG8_LAS unsigned char* lds, const Gemm g, const Sched& S, const Epi& E) {
  int tid = threadIdx.x; asm volatile("" : "+v"(tid));
  const int wid = __builtin_amdgcn_readfirstlane(tid >> 6), lane = tid & 63, wr = wid >> 2, wc = wid & 3, fr = lane & 15, fq = lane >> 4;
  const int K = g.K, nt = K / BK, ld = g.ld;
  unsigned voffA[2], voffB[2];
#pragma unroll
  for (int i = 0; i < 2; ++i) { int R, C; stage_rc(tid * 16 + i * 8192, R, C); const int Rb = Epi::PERM ? ((R & ~31) + perm32(R & 31)) : R;
    voffA[i] = (unsigned)(R * ld + C) * 2u; voffB[i] = (unsigned)(Rb * ld + C) * 2u; }
  const size_t kstep = (size_t)(BK * 2);
  const size_t hstep = (size_t)HALF * ld * 2;
  const size_t tstep = 2 * hstep;
  const unsigned ldsw = (unsigned)wid * 1024u;
  const int aoff = lds_byte(wr * 64 + fr, fq * 8), boff = lds_byte(wc * 32 + fr, fq * 8);
#define PG8_SA(b, h) (((b) * 2 + (h)) * HTB)
#define PG8_SB(b, h) ((4 + (b) * 2 + (h)) * HTB)
#define PG8_STAGE(bufoff, gbase, voff) do { _Pragma("unroll") for (int _i = 0; _i < 2; ++_i) \
    __builtin_amdgcn_global_load_lds((const unsigned*)((const char*)(gbase) + (voff)[_i]), (PG8_LAS unsigned*)(lds + (bufoff) + ldsw + _i * 8192), 16, 0, 0); } while (0)
#define PG8_LDA(dst, b, h) do { _Pragma("unroll") for (int m = 0; m < 4; ++m) _Pragma("unroll") for (int k = 0; k < 2; ++k) dst[m][k] = *(const PG8_LAS bf16x8*)(lds + PG8_SA(b, h) + aoff + m * 2048 + k * 1024); } while (0)
#define PG8_LDB(dst, b, h) do { _Pragma("unroll") for (int n = 0; n < 2; ++n) _Pragma("unroll") for (int k = 0; k < 2; ++k) dst[n][k] = *(const PG8_LAS bf16x8*)(lds + PG8_SB(b, h) + boff + n * 2048 + k * 1024); } while (0)
#define PG8_MMA(ai, bj, At, Bt) do { __builtin_amdgcn_s_setprio(1); _Pragma("unroll") for (int m = 0; m < 4; ++m) _Pragma("unroll") for (int n = 0; n < 2; ++n) _Pragma("unroll") for (int k = 0; k < 2; ++k) \
    acc[ai][bj][m][n] = __builtin_amdgcn_mfma_f32_16x16x32_bf16(Bt[n][k], At[m][k], acc[ai][bj][m][n], 0, 0, 0); __builtin_amdgcn_s_setprio(0); } while (0)
#define PG8_WAIT_V(n) asm volatile("s_waitcnt vmcnt(" #n ")" ::: "memory")
#define PG8_WAIT_L(n) asm volatile("s_waitcnt lgkmcnt(" #n ")" ::: "memory")
#define PG8_BAR __builtin_amdgcn_s_barrier()
#define PG8_SCHED __builtin_amdgcn_sched_barrier(0)
  Unit cur, nxt; int ui = 0;
  if (!S.next(0, cur)) return;
  f32x4 acc[2][2][4][2];
#pragma unroll
  for (int a = 0; a < 2; ++a)
#pragma unroll
    for (int b = 0; b < 2; ++b)
#pragma unroll
      for (int m = 0; m < 4; ++m)
#pragma unroll
        for (int n = 0; n < 2; ++n) acc[a][b][m][n] = (f32x4){0.f, 0.f, 0.f, 0.f};
  bf16x8 At[4][2], B0[2][2], B1[2][2];
  const char* cA = (const char*)g.A + (size_t)cur.pm * tstep; const char* cB = (const char*)g.Bt + (size_t)cur.pn * tstep;
  PG8_STAGE(PG8_SB(0, 0), cB, voffB); PG8_STAGE(PG8_SA(0, 0), cA, voffA); PG8_STAGE(PG8_SB(0, 1), cB + hstep, voffB); PG8_STAGE(PG8_SA(0, 1), cA + hstep, voffA);
  if (wr == 1) PG8_BAR;
  PG8_WAIT_V(4); PG8_BAR;
  PG8_STAGE(PG8_SB(1, 0), cB + kstep, voffB); PG8_STAGE(PG8_SA(1, 0), cA + kstep, voffA); PG8_STAGE(PG8_SB(1, 1), cB + hstep + kstep, voffB);
  PG8_WAIT_V(6); PG8_BAR;
  for (;;) {
    const bool has_next = S.next(ui + 1, nxt);
    const char* nA = has_next ? (const char*)g.A + (size_t)nxt.pm * tstep : cA; const char* nB = has_next ? (const char*)g.Bt + (size_t)nxt.pn * tstep : cB;
    for (int t = 0; t < nt; t += 2) {
      const bool last = (t == nt - 2);
      const char* a1 = cA + (size_t)(t + 1) * kstep;
      const char* a2 = last ? nA : cA + (size_t)(t + 2) * kstep; const char* b2 = last ? nB : cB + (size_t)(t + 2) * kstep;
      const char* a3 = a2 + kstep; const char* b3 = b2 + kstep;
      PG8_LDB(B0, 0, 0); PG8_SCHED; PG8_LDA(At, 0, 0); PG8_STAGE(PG8_SA(1, 1), a1 + hstep, voffA);
      PG8_WAIT_L(8); PG8_BAR; PG8_WAIT_L(0); PG8_MMA(0, 0, At, B0); PG8_BAR; PG8_SCHED;
      PG8_LDB(B1, 0, 1); PG8_STAGE(PG8_SB(0, 0), b2, voffB);
      PG8_BAR; PG8_WAIT_L(0); PG8_MMA(0, 1, At, B1); PG8_BAR;
      PG8_LDA(At, 0, 1); PG8_STAGE(PG8_SA(0, 0), a2, voffA);
      PG8_BAR; PG8_WAIT_L(0); PG8_MMA(1, 0, At, B0); PG8_BAR; PG8_SCHED;
      PG8_STAGE(PG8_SB(0, 1), b2 + hstep, voffB);
      PG8_WAIT_V(6); PG8_BAR; PG8_MMA(1, 1, At, B1); PG8_BAR;
      PG8_LDB(B0, 1, 0); PG8_SCHED; PG8_LDA(At, 1, 0); PG8_STAGE(PG8_SA(0, 1), a2 + hstep, voffA);
      PG8_WAIT_L(8); PG8_BAR; PG8_WAIT_L(0); PG8_MMA(0, 0, At, B0); PG8_BAR; PG8_SCHED;
      PG8_LDB(B1, 1, 1); PG8_STAGE(PG8_SB(1, 0), b3, voffB);
      PG8_BAR; PG8_WAIT_L(0); PG8_MMA(0, 1, At, B1); PG8_BAR;
      PG8_LDA(At, 1, 1); PG8_STAGE(PG8_SA(1, 0), a3, voffA);
      PG8_BAR; PG8_WAIT_L(0); PG8_MMA(1, 0, At, B0); PG8_BAR; PG8_SCHED;
      PG8_STAGE(PG8_SB(1, 1), b3 + hstep, voffB);
      PG8_WAIT_V(6); PG8_BAR; PG8_MMA(1, 1, At, B1); PG8_BAR;
    }
    E(acc, cur, wr, wc, fr, fq);
    if (!has_next) break;
#pragma unroll
    for (int a = 0; a < 2; ++a)
#pragma unroll
      for (int b = 0; b < 2; ++b)
#pragma unroll
        for (int m = 0; m < 4; ++m)
#pragma unroll
          for (int n = 0; n < 2; ++n) acc[a][b][m][n] = (f32x4){0.f, 0.f, 0.f, 0.f};
    cur = nxt; cA = nA; cB = nB; ++ui;
  }
  PG8_WAIT_V(0);
  if (wr == 0) PG8_BAR;
  PG8_BAR;
#undef PG8_SA
#undef PG8_SB
#undef PG8_STAGE
#undef PG8_LDA
#undef PG8_LDB
#undef PG8_MMA
#undef PG8_WAIT_V
#undef PG8_WAIT_L
#undef PG8_BAR
#undef PG8_SCHED
}
}

DI void phase_inproj(const Params& p, int l, unsigned char* smem_base) {
  pg8::Gemm g; g.A = (const u16*)(p.ws + OFF_H); g.Bt = (const u16*)(p.ws + OFF_WIN) + (size_t)l * LDZ * LDH; g.M = MTOK; g.N = LDZ; g.K = DM; g.ld = LDH;
  pg8::StaticOrder S; S.init(MTOK, LDZ, gridDim.x, blockIdx.x);
  pg8::EpiBf16 E; E.O = (u16*)(p.ws + OFF_Z); E.ldc = LDZ;
  pg8::gemm_phase(( PG8_LAS unsigned char*)smem_base, g, S, E);
}

template <int NKT>
DI void attn_scores(f32x4 (&S)[NKT], const u16* sKw, const bf16x8 (&qf)[4], int lane) {
#pragma unroll
  for (int kt = 0; kt < NKT; ++kt) {
    S[kt] = f32x4{0.f, 0.f, 0.f, 0.f};
#pragma unroll
    for (int ks = 0; ks < 4; ++ks) {
      const bf16x8 kf = ldfrag(sKw + (kt * 16 + (lane & 15)) * 136 + ks * 32 + (lane >> 4) * 8);
      S[kt] = mfma16(kf, qf[ks], S[kt]);
    }
  }
}
template <int NKT>
DI void attn_pv(f32x4 (&O)[8], const f32x4 (&P)[NKT], const u16* sVTw, int ldv, int lane) {
#pragma unroll
  for (int ct = 0; ct < 8; ++ct) O[ct] = f32x4{0.f, 0.f, 0.f, 0.f};
#pragma unroll
  for (int pp = 0; pp < NKT / 2; ++pp) {
    bf16x8 pf;
#pragma unroll
    for (int j = 0; j < 4; ++j) { pf[j] = (short)f2bf(P[2 * pp][j]); pf[4 + j] = (short)f2bf(P[2 * pp + 1][j]); }
#pragma unroll
    for (int ct = 0; ct < 8; ++ct) {
      const u16* vp = sVTw + (ct * 16 + (lane & 15)) * ldv + (2 * pp) * 16 + (lane >> 4) * 4;
      const s16x4 lo = *(const s16x4*)vp;
      const s16x4 hi = *(const s16x4*)(vp + 16);
      const bf16x8 vf = __builtin_shufflevector(lo, hi, 0, 1, 2, 3, 4, 5, 6, 7);
      O[ct] = mfma16(vf, pf, O[ct]);
    }
  }
}

typedef short v4i16_t __attribute__((ext_vector_type(4)));
template <int NKT>
DI void attn_pv_tr(f32x4 (&O)[8], const f32x4 (&P)[NKT], const u16* sVw, int ldv, int lane) {
#pragma unroll
  for (int ct = 0; ct < 8; ++ct) O[ct] = f32x4{0.f, 0.f, 0.f, 0.f};
#pragma unroll
  for (int pp = 0; pp < NKT / 2; ++pp) {
    bf16x8 pf;
#pragma unroll
    for (int j = 0; j < 4; ++j) { pf[j] = (short)f2bf(P[2 * pp][j]); pf[4 + j] = (short)f2bf(P[2 * pp + 1][j]); }
    const u16* vrow = sVw + ((2 * pp) * 16 + (lane >> 4) * 4 + ((lane & 15) >> 2)) * ldv + (lane & 3) * 4;
#pragma unroll
    for (int ct = 0; ct < 8; ++ct) {
      const s16x4 lo = __builtin_bit_cast(s16x4, __builtin_amdgcn_ds_read_tr16_b64_v4i16((__attribute__((address_space(3))) v4i16_t*)(vrow + ct * 16)));
      const s16x4 hi = __builtin_bit_cast(s16x4, __builtin_amdgcn_ds_read_tr16_b64_v4i16((__attribute__((address_space(3))) v4i16_t*)(vrow + 16 * ldv + ct * 16)));
      const bf16x8 vf = __builtin_shufflevector(lo, hi, 0, 1, 2, 3, 4, 5, 6, 7);
      O[ct] = mfma16(vf, pf, O[ct]);
    }
  }
}

DI void unit_attnA(const Params& p, const Bucket& bk, const SB& sb, int u, unsigned char* smem, int dry) {
  u16* Z = (u16*)(p.ws + OFF_Z);
  float* LSE = (float*)(p.ws + OFF_LSE);
  u16* sK = (u16*)smem;
  float* sBias = (float*)(smem + 59904);
  const int tid = TIDX(), lane = tid & 63, w = tid >> 6;
  const int L = sb.L, B = sb.B, nblk = L / 64;
  const int blk = u % nblk; int t = u / nblk; const int b = t % B; const int gh = t / B; const int g = gh >> 2, h = gh & 3;
  const int d = (g == 0) ? 1 : (g == 1 ? 4 : 16);
  const int M = L / d, nbr = M / 64, r = blk / nbr, m0 = (blk % nbr) * 64;
  const size_t rowbase = (size_t)b * L;
  const int qcol = C_QA + g * 512 + h * 128, kcol = C_KA + g * 512 + h * 128, vcol = C_VA + g * 512 + h * 128;
  __syncthreads();
  if (tid < 129) sBias[tid] = ((const float*)(p.ws + OFF_DFT + 98304))[(g * 4 + h) * 129 + tid];
  for (int id = tid; id < 208 * 16; id += 256) {
    const int kk = id >> 4, ch = id & 15;
    const int km = m0 - 64 + kk;
    const int kmc = min(max(km, 0), M - 1);
    u32x4 v = *(const u32x4*)(Z + (rowbase + (size_t)kmc * d + r) * LDZ + kcol + ch * 8);
    if (km != kmc) v = u32x4{0u, 0u, 0u, 0u};
    *(u32x4*)(sK + kk * 136 + ch * 8) = v;
  }
  bf16x8 qf[4];
  const size_t qrow = rowbase + (size_t)(m0 + w * 16 + (lane & 15)) * d + r;
#pragma unroll
  for (int ks = 0; ks < 4; ++ks) qf[ks] = ldfrag(Z + qrow * LDZ + qcol + ks * 32 + (lane >> 4) * 8);
  u32x4 vreg[13];
#pragma unroll
  for (int i = 0; i < 13; ++i) {
    const int id = tid + i * 256, kk = id >> 4, ch = id & 15;
    const int km = m0 - 64 + kk;
    const int kmc = min(max(km, 0), M - 1);
    vreg[i] = *(const u32x4*)(Z + (rowbase + (size_t)kmc * d + r) * LDZ + vcol + ch * 8);
    if (km != kmc) vreg[i] = u32x4{0u, 0u, 0u, 0u};
  }
  __syncthreads();
  f32x4 S[10];
  attn_scores<10>(S, sK + (w * 16) * 136, qf, lane);
  float mx = -3.0e38f;
#pragma unroll
  for (int kt = 0; kt < 10; ++kt)
#pragma unroll
    for (int i = 0; i < 4; ++i) {
      const int kkr = kt * 16 + (lane >> 4) * 4 + i;
      const int rel = kkr - 64 - (lane & 15);
      const int km = m0 - 64 + w * 16 + kkr;
      const bool ok = (rel >= -64) && (rel <= 64) && (km >= 0) && (km < M);
      const int bi = min(max(rel + 64, 0), 128);
      const float s = ok ? S[kt][i] * QSCALE + sBias[bi] : -1e30f;
      S[kt][i] = s;
      mx = fmaxf(mx, s);
    }
  mx = fmaxf(mx, __shfl_xor(mx, 16));
  mx = fmaxf(mx, __shfl_xor(mx, 32));
  float sum = 0.f;
#pragma unroll
  for (int kt = 0; kt < 10; ++kt)
#pragma unroll
    for (int i = 0; i < 4; ++i) { const float e = __expf(S[kt][i] - mx); S[kt][i] = e; sum += e; }
  sum += __shfl_xor(sum, 16);
  sum += __shfl_xor(sum, 32);
  __syncthreads();
  u16* sV = sK;
#pragma unroll
  for (int i = 0; i < 13; ++i) {
    const int id = tid + i * 256, kk = id >> 4, ch = id & 15;
    *(u32x4*)(sV + kk * 144 + ch * 8) = vreg[i];
  }
  __syncthreads();
  f32x4 O[8];
  attn_pv_tr<10>(O, S, sV + (w * 16) * 144, 144, lane);
  const float inv = __builtin_amdgcn_rcpf(sum);
  if (!dry) {
#pragma unroll
    for (int ct = 0; ct < 8; ++ct) {
      u32x2 o; o.x = pack2(O[ct][0] * inv, O[ct][1] * inv); o.y = pack2(O[ct][2] * inv, O[ct][3] * inv);
      *(u32x2*)(Z + qrow * LDZ + qcol + ct * 16 + (lane >> 4) * 4) = o;
    }
  }
  if ((lane >> 4) == 0) LSE[qrow * 12 + g * 4 + h] = mx + __logf(sum);
}

DI void unit_attnD(const Params& p, const SB& sb, int l, int u, unsigned char* smem) {
  const u16* Z = (const u16*)(p.ws + OFF_Z);
  u16* GATED = (u16*)(p.ws + OFF_GATED);
  u16* sK = (u16*)smem;
  const int tid = TIDX(), lane = tid & 63, w = tid >> 6;
  const int h = u & 3, rb = u >> 2;
  const int row0 = rb * 64;
  const int b = row0 / sb.L;
  const size_t kvbase = ((size_t)(l * 6 + sb.memb + b) * 4 + h) * 256 * 128;
  const u16* KVK = (const u16*)(p.ws + OFF_KVK) + kvbase;
  const u16* KVV = (const u16*)(p.ws + OFF_KVV) + kvbase;
  __syncthreads();
  for (int id = tid; id < 256 * 16; id += 256) {
    const int m = id >> 4, ch = id & 15;
    *(u32x4*)(sK + m * 136 + ch * 8) = *(const u32x4*)(KVK + m * 128 + ch * 8);
  }
  bf16x8 qf[4];
  const size_t qrow = (size_t)row0 + w * 16 + (lane & 15);
#pragma unroll
  for (int ks = 0; ks < 4; ++ks) qf[ks] = ldfrag(Z + qrow * LDZ + C_QD + h * 128 + ks * 32 + (lane >> 4) * 8);
  __syncthreads();
  f32x4 S[16];
  attn_scores<16>(S, sK, qf, lane);
  float mx = -3.0e38f;
#pragma unroll
  for (int kt = 0; kt < 16; ++kt)
#pragma unroll
    for (int i = 0; i < 4; ++i) { S[kt][i] *= QSCALE; mx = fmaxf(mx, S[kt][i]); }
  mx = fmaxf(mx, __shfl_xor(mx, 16));
  mx = fmaxf(mx, __shfl_xor(mx, 32));
  float sum = 0.f;
#pragma unroll
  for (int kt = 0; kt < 16; ++kt)
#pragma unroll
    for (int i = 0; i < 4; ++i) { const float e = __expf(S[kt][i] - mx); S[kt][i] = e; sum += e; }
  sum += __shfl_xor(sum, 16);
  sum += __shfl_xor(sum, 32);
  __syncthreads();
  u16* sVT = sK;
  for (int id = tid; id < 128 * 32; id += 256) {
    const int c = id >> 5, ch = id & 31;
    *(u32x4*)(sVT + c * 264 + ch * 8) = *(const u32x4*)(KVV + c * 256 + ch * 8);
  }
  __syncthreads();
  f32x4 O[8];
  attn_pv<16>(O, S, sVT, 264, lane);
  const float inv = __builtin_amdgcn_rcpf(sum);
#pragma unroll
  for (int ct = 0; ct < 8; ++ct) {
    const int c = h * 128 + ct * 16 + (lane >> 4) * 4;
    u32x2 o;
    o.x = pack2(O[ct][0] * inv, O[ct][1] * inv);
    o.y = pack2(O[ct][2] * inv, O[ct][3] * inv);
    *(u32x2*)(GATED + qrow * LDG + 1536 + c) = o;
  }
}

DI void conv8(const u16* __restrict__ Zb, int L, int pos, int col, const float* __restrict__ cw, int cwcol, float (&o)[8]) {
  float a[8];
#pragma unroll
  for (int e = 0; e < 8; ++e) a[e] = 0.f;
  u32x4 zv[5];
#pragma unroll
  for (int j = 0; j < 5; ++j) {
    const int pp = min(max(pos + j - 2, 0), L - 1);
    zv[j] = *(const u32x4*)(Zb + (size_t)pp * LDZ + col);
  }
#pragma unroll
  for (int j = 0; j < 5; ++j) {
    const int pp = pos + j - 2;
    const float ok = (pp >= 0 && pp < L) ? 1.f : 0.f;
    float f[8];
    unpack8(zv[j], f);
    const float4 w0 = *(const float4*)(cw + j * 1024 + cwcol);
    const float4 w1 = *(const float4*)(cw + j * 1024 + cwcol + 4);
    a[0] += f[0] * (w0.x * ok); a[1] += f[1] * (w0.y * ok); a[2] += f[2] * (w0.z * ok); a[3] += f[3] * (w0.w * ok);
    a[4] += f[4] * (w1.x * ok); a[5] += f[5] * (w1.y * ok); a[6] += f[6] * (w1.z * ok); a[7] += f[7] * (w1.w * ok);
  }
#pragma unroll
  for (int e = 0; e < 8; ++e) o[e] = siluf_(a[e]);
}
DI void gate_stats(const Params& p, const u16* Zrow0  , int l, int h, int dir, int lane, int& t, float& bcum, float& uu, float& g) {
  t = dir ? 63 - lane : lane;
  const u16* zr = Zrow0 + (size_t)t * LDZ + C_GC + dir * 8 + h;
  const float ip = bf2f(zr[0]) + p.gate_bias[l * 16 + dir * 8 + h];
  const float fp = bf2f(zr[4]) + p.gate_bias[l * 16 + dir * 8 + 4 + h];
  float v = logsigf_(fp);
#pragma unroll
  for (int o = 1; o < 64; o <<= 1) { const float n = __shfl_up(v, o); if (lane >= o) v += n; }
  bcum = v;
  g = __shfl(v, 63);
  uu = ip - v;
}

DI void unit_mlstm_local(const Params& p, const SB& sb, int l, int u, unsigned char* smem) {
  const u16* Z = (const u16*)(p.ws + OFF_Z);
  u16* CS = (u16*)(p.ws + OFF_CS);
  float* NS = (float*)(p.ws + OFF_NS);
  float* SCG = (float*)(p.ws + OFF_SC);
  float* SCMA = SCG + 2048;
  u16* sKW = (u16*)smem;
  u16* sVT = sKW + 2 * 128 * 72;
  float* sWa = (float*)(sVT + 128 * 72);
  const int tid = TIDX(), lane = tid & 63, w = tid >> 6;
  const int N = sb.L / 64;
  const int h = u & 3; int cidx = u >> 2; const int n = cidx % N, b = cidx / N;
  const size_t row0 = (size_t)b * sb.L + (size_t)n * 64;
  __syncthreads();
  if (w < 2) {
    int t; float bc, uu, g;
    gate_stats(p, Z + row0 * LDZ, l, h, w, lane, t, bc, uu, g);
    const float a = g + uu;
    const float ma = wmaxr(a);
    sWa[w * 64 + t] = __expf(a - ma);
    if (lane == 0) { const int seq = (b * 4 + h) * 2 + w; SCG[seq * N + n] = g; SCMA[seq * N + n] = ma; }
  }
  __syncthreads();
  const u16* Zb = Z + (size_t)b * sb.L * LDZ;
  const float* cw = p.conv_qk + (size_t)l * 5 * 1024;
#pragma unroll 1
  for (int i = 0; i < 4; ++i) {
    const int id = tid + i * 256, t = id & 63, ch = id >> 6;
    float km[8];
    conv8(Zb, sb.L, n * 64 + t, C_KC + h * 128 + ch * 8, cw, 512 + h * 128 + ch * 8, km);
    const float wf = sWa[t], wb = sWa[64 + t];
    const u32x4 vv = *(const u32x4*)(Z + (row0 + t) * LDZ + C_VC + h * 128 + ch * 8);
    const unsigned vw[4] = {vv.x, vv.y, vv.z, vv.w};
#pragma unroll
    for (int e = 0; e < 8; ++e) {
      sKW[(ch * 8 + e) * 72 + t] = f2bf(km[e] * wf);
      sKW[(128 + ch * 8 + e) * 72 + t] = f2bf(km[e] * wb);
      sVT[(ch * 8 + e) * 72 + t] = (u16)((e & 1) ? (vw[e >> 1] >> 16) : (vw[e >> 1] & 0xffff));
    }
  }
  __syncthreads();
  {
    const int dir = tid >> 7, dd = tid & 127;
    float s = 0.f;
    const u16* kp = sKW + (dir * 128 + dd) * 72;
#pragma unroll 8
    for (int t = 0; t < 64; ++t) s += bf2f(kp[t]);
    const int seq = (b * 4 + h) * 2 + dir;
    NS[((size_t)seq * N + n) * 128 + dd] = s;
  }
#pragma unroll 1
  for (int dir = 0; dir < 2; ++dir) {
    f32x4 acc[2][8];
#pragma unroll
    for (int a = 0; a < 2; ++a)
#pragma unroll
      for (int c = 0; c < 8; ++c) acc[a][c] = f32x4{0.f, 0.f, 0.f, 0.f};
#pragma unroll
    for (int ks = 0; ks < 2; ++ks) {
      bf16x8 af[2], bfv[8];
#pragma unroll
      for (int mt = 0; mt < 2; ++mt) af[mt] = ldfrag(sKW + (dir * 128 + w * 32 + mt * 16 + (lane & 15)) * 72 + ks * 32 + (lane >> 4) * 8);
#pragma unroll
      for (int nt = 0; nt < 8; ++nt) bfv[nt] = ldfrag(sVT + (nt * 16 + (lane & 15)) * 72 + ks * 32 + (lane >> 4) * 8);
#pragma unroll
      for (int mt = 0; mt < 2; ++mt)
#pragma unroll
        for (int nt = 0; nt < 8; ++nt) acc[mt][nt] = mfma16(af[mt], bfv[nt], acc[mt][nt]);
    }
    const int seq = (b * 4 + h) * 2 + dir;
    u16* cs = CS + ((size_t)seq * N + n) * 16384;
#pragma unroll
    for (int mt = 0; mt < 2; ++mt)
#pragma unroll
      for (int nt = 0; nt < 8; ++nt) {
        const int e = nt * 16 + (lane & 15), dd = w * 32 + mt * 16 + (lane >> 4) * 4;
        u32x2 o; o.x = pack2(acc[mt][nt][0], acc[mt][nt][1]); o.y = pack2(acc[mt][nt][2], acc[mt][nt][3]);
        *(u32x2*)(cs + e * 128 + dd) = o;
      }
  }
}

DI void unit_mlstm_scan(const Params& p, const SB& sb, int u, unsigned char* smem, int dry) {
  u16* CS = (u16*)(p.ws + OFF_CS);
  float* NS = (float*)(p.ws + OFF_NS);
  const float* SCG = (const float*)(p.ws + OFF_SC);
  const float* SCMA = SCG + 2048;
  float* SCMP = (float*)(p.ws + OFF_SC) + 4096;
  float* sOld = (float*)smem;
  float* sNew = sOld + 256;
  const int tid = TIDX();
  const int N = sb.L / 64;
  const int seq = u >> 5, slab = u & 31, dir = seq & 1;
  __syncthreads();
  if (tid < N) { sOld[tid] = SCG[seq * N + tid]; sNew[tid] = SCMA[seq * N + tid]; }
  __syncthreads();
  if (tid == 0) {
    float m = 0.f;
    for (int i = 0; i < N; ++i) {
      const int n = dir ? N - 1 - i : i;
      const float g = sOld[n], ma = sNew[n];
      const float mn = fmaxf(g + m, ma);
      sOld[n] = __expf(g + m - mn);
      sNew[n] = __expf(ma - mn);
      if (slab == 0) SCMP[seq * N + n] = m;
      m = mn;
    }
  }
  __syncthreads();
  unsigned* cs = (unsigned*)(CS + (size_t)seq * N * 16384) + slab * 256 + tid;
  float c0 = 0.f, c1 = 0.f;
  for (int i0 = 0; i0 < N; i0 += 32) {
    unsigned v[32];
#pragma unroll
    for (int j = 0; j < 32; ++j) { const int n = dir ? N - 1 - (i0 + j) : i0 + j; v[j] = cs[(size_t)n * 8192]; }
#pragma unroll
    for (int j = 0; j < 32; ++j) {
      const int n = dir ? N - 1 - (i0 + j) : i0 + j;
      if (!dry) cs[(size_t)n * 8192] = pack2(c0, c1);
      const float so = sOld[n], sn = sNew[n];
      c0 = so * c0 + sn * bflo(v[j]);
      c1 = so * c1 + sn * bfhi(v[j]);
    }
  }
  if (slab == 0 && tid < 128) {
    float* ns = NS + (size_t)seq * N * 128 + tid;
    float a = 0.f;
    for (int i0 = 0; i0 < N; i0 += 16) {
      float v[16];
#pragma unroll
      for (int j = 0; j < 16; ++j) { const int n = dir ? N - 1 - (i0 + j) : i0 + j; v[j] = ns[(size_t)n * 128]; }
#pragma unroll
      for (int j = 0; j < 16; ++j) {
        const int n = dir ? N - 1 - (i0 + j) : i0 + j;
        if (!dry) ns[(size_t)n * 128] = a;
        a = sOld[n] * a + sNew[n] * v[j];
      }
    }
  }
}

DI void unit_mlstm_out(const Params& p, const SB& sb, int l, int u, unsigned char* smem) {
  const u16* Z = (const u16*)(p.ws + OFF_Z);
  const u16* CS = (const u16*)(p.ws + OFF_CS);
  const float* NS = (const float*)(p.ws + OFF_NS);
  const float* SCMP = (const float*)(p.ws + OFF_SC) + 4096;
  u16* GATED = (u16*)(p.ws + OFF_GATED);
  u16* sQ = (u16*)smem;
  u16* sK = sQ + 64 * 136;
  u16* sV = sK + 64 * 136;
  u16* sSQ = sV + 64 * 144;
  float* sU = (float*)(sSQ + 64 * 72);
  float* sMx = sU + 128;
  float* sB = sMx + 128;
  float* sNp = sB + 128;
  float* sMp = sNp + 256;
  const int tid = TIDX(), lane = tid & 63, w = tid >> 6;
  const int N = sb.L / 64;
  const int h = u & 3; int cidx = u >> 2; const int n = cidx % N, b = cidx / N;
  const size_t row0 = (size_t)b * sb.L + (size_t)n * 64;
  const int seq0 = (b * 4 + h) * 2;
  __syncthreads();
  if (w < 2) {
    int t; float bc, uu, g;
    gate_stats(p, Z + row0 * LDZ, l, h, w, lane, t, bc, uu, g);
    float pm = uu;
#pragma unroll
    for (int o = 1; o < 64; o <<= 1) { const float nn = __shfl_up(pm, o); if (lane >= o) pm = fmaxf(pm, nn); }
    const float mp = SCMP[(seq0 + w) * N + n];
    sU[w * 64 + t] = uu;
    sMx[w * 64 + t] = fmaxf(mp, pm);
    sB[w * 64 + t] = bc;
    if (lane == 0) sMp[w] = mp;
  }
  {
    const int dir = tid >> 7, dd = tid & 127;
    sNp[tid] = NS[((size_t)(seq0 + dir) * N + n) * 128 + dd];
  }
  const u16* Zb = Z + (size_t)b * sb.L * LDZ;
  const float* cw = p.conv_qk + (size_t)l * 5 * 1024;
#pragma unroll 1
  for (int i = 0; i < 4; ++i) {
    const int id = tid + i * 256, ch = id & 15, t = id >> 4;
    float qm[8], km[8];
    const u32x4 vv = *(const u32x4*)(Z + (row0 + t) * LDZ + C_VC + h * 128 + ch * 8);
    conv8(Zb, sb.L, n * 64 + t, C_QC + h * 128 + ch * 8, cw, h * 128 + ch * 8, qm);
    conv8(Zb, sb.L, n * 64 + t, C_KC + h * 128 + ch * 8, cw, 512 + h * 128 + ch * 8, km);
    u32x4 qo, ko;
    qo.x = pack2(qm[0] * QSCALE, qm[1] * QSCALE); qo.y = pack2(qm[2] * QSCALE, qm[3] * QSCALE);
    qo.z = pack2(qm[4] * QSCALE, qm[5] * QSCALE); qo.w = pack2(qm[6] * QSCALE, qm[7] * QSCALE);
    ko.x = pack2(km[0], km[1]); ko.y = pack2(km[2], km[3]); ko.z = pack2(km[4], km[5]); ko.w = pack2(km[6], km[7]);
    *(u32x4*)(sQ + t * 136 + ch * 8) = qo;
    *(u32x4*)(sK + t * 136 + ch * 8) = ko;
    *(u32x4*)(sV + t * 144 + ch * 8) = vv;
  }
  __syncthreads();
  const int tq = w * 16 + (lane & 15);
  f32x4 S[4];
  {
    bf16x8 qf[4];
#pragma unroll
    for (int ks = 0; ks < 4; ++ks) qf[ks] = ldfrag(sQ + tq * 136 + ks * 32 + (lane >> 4) * 8);
#pragma unroll
    for (int mt = 0; mt < 4; ++mt) {
      S[mt] = f32x4{0.f, 0.f, 0.f, 0.f};
#pragma unroll
      for (int ks = 0; ks < 4; ++ks) {
        const bf16x8 kf = ldfrag(sK + (mt * 16 + (lane & 15)) * 136 + ks * 32 + (lane >> 4) * 8);
        S[mt] = mfma16(kf, qf[ks], S[mt]);
      }
    }
  }
  f32x4 hc[8];
#pragma unroll
  for (int mt = 0; mt < 8; ++mt) hc[mt] = f32x4{0.f, 0.f, 0.f, 0.f};
#pragma unroll 1
  for (int dir = 0; dir < 2; ++dir) {
    const float Mx = sMx[dir * 64 + tq];
    const float mp = sMp[dir];
    const float winter = __expf(mp - Mx);
    const float em = __expf(-(sB[dir * 64 + tq] + Mx));
    float dq = 0.f;
    {
      const u16* qp = sQ + tq * 136 + (lane >> 4) * 32;
      const float* np_ = sNp + dir * 128 + (lane >> 4) * 32;
#pragma unroll 8
      for (int j = 0; j < 32; ++j) dq += bf2f(qp[j]) * np_[j];
    }
    dq += __shfl_xor(dq, 16);
    dq += __shfl_xor(dq, 32);
    float dsum = 0.f;
    __syncthreads();
#pragma unroll
    for (int mt = 0; mt < 4; ++mt) {
      float v[4];
#pragma unroll
      for (int i = 0; i < 4; ++i) {
        const int s = mt * 16 + (lane >> 4) * 4 + i;
        const bool ok = dir ? (s >= tq) : (s <= tq);
        const float wi = ok ? __expf(fminf(sU[dir * 64 + s] - Mx, 0.f)) : 0.f;
        v[i] = S[mt][i] * wi;
        dsum += v[i];
      }
      u32x2 o; o.x = pack2(v[0], v[1]); o.y = pack2(v[2], v[3]);
      *(u32x2*)(sSQ + tq * 72 + mt * 16 + (lane >> 4) * 4) = o;
    }
    dsum += __shfl_xor(dsum, 16);
    dsum += __shfl_xor(dsum, 32);
    const float den = winter * dq + dsum;
    const float rden = __builtin_amdgcn_rcpf(fmaxf(fabsf(den), em));
    __syncthreads();
    const u16* cs = CS + ((size_t)(seq0 + dir) * N + n) * 16384;
    f32x4 acc[8];
#pragma unroll
    for (int mt = 0; mt < 8; ++mt) acc[mt] = f32x4{0.f, 0.f, 0.f, 0.f};
#pragma unroll
    for (int ks = 0; ks < 4; ++ks) {
      const bf16x8 qf = ldfrag(sQ + tq * 136 + ks * 32 + (lane >> 4) * 8);
#pragma unroll
      for (int mt = 0; mt < 8; ++mt) {
        const bf16x8 cf = ldfrag(cs + (mt * 16 + (lane & 15)) * 128 + ks * 32 + (lane >> 4) * 8);
        acc[mt] = mfma16(cf, qf, acc[mt]);
      }
    }
#pragma unroll
    for (int mt = 0; mt < 8; ++mt)
#pragma unroll
      for (int i = 0; i < 4; ++i) acc[mt][i] *= winter;
#pragma unroll
    for (int ks = 0; ks < 2; ++ks) {
      const bf16x8 pf = ldfrag(sSQ + tq * 72 + ks * 32 + (lane >> 4) * 8);
#pragma unroll
      for (int mt = 0; mt < 8; ++mt) {
        const u16* vp = sV + (ks * 32 + (lane >> 4) * 8 + ((lane & 15) >> 2)) * 144 + mt * 16 + (lane & 3) * 4;
        const s16x4 vlo = __builtin_bit_cast(s16x4, __builtin_amdgcn_ds_read_tr16_b64_v4i16((__attribute__((address_space(3))) v4i16_t*)vp));
        const s16x4 vhi = __builtin_bit_cast(s16x4, __builtin_amdgcn_ds_read_tr16_b64_v4i16((__attribute__((address_space(3))) v4i16_t*)(vp + 4 * 144)));
        const bf16x8 vf = __builtin_shufflevector(vlo, vhi, 0, 1, 2, 3, 4, 5, 6, 7);
        acc[mt] = mfma16(vf, pf, acc[mt]);
      }
    }
#pragma unroll
    for (int mt = 0; mt < 8; ++mt)
#pragma unroll
      for (int i = 0; i < 4; ++i) hc[mt][i] += acc[mt][i] * rden;
  }
  const size_t row = row0 + tq;
  float s1 = 0.f;
#pragma unroll
  for (int mt = 0; mt < 8; ++mt) {
    const u32x2 oc = *(const u32x2*)(Z + row * LDZ + C_OC + h * 128 + mt * 16 + (lane >> 4) * 4);
    hc[mt][0] *= sigmoidf_(bflo(oc.x)); hc[mt][1] *= sigmoidf_(bfhi(oc.x));
    hc[mt][2] *= sigmoidf_(bflo(oc.y)); hc[mt][3] *= sigmoidf_(bfhi(oc.y));
    s1 += hc[mt][0] + hc[mt][1] + hc[mt][2] + hc[mt][3];
  }
  s1 += __shfl_xor(s1, 16);
  s1 += __shfl_xor(s1, 32);
  const float mu = s1 * (1.f / 128.f);
  float s2 = 0.f;
#pragma unroll
  for (int mt = 0; mt < 8; ++mt)
#pragma unroll
    for (int i = 0; i < 4; ++i) { const float dlt = hc[mt][i] - mu; s2 += dlt * dlt; }
  s2 += __shfl_xor(s2, 16);
  s2 += __shfl_xor(s2, 32);
  const float rs = rsqrtf(s2 * (1.f / 128.f) + EPSV);
#pragma unroll
  for (int mt = 0; mt < 8; ++mt) {
    const int c = h * 128 + mt * 16 + (lane >> 4) * 4;
    const float4 hg = *(const float4*)(p.head_gain + l * 512 + c);
    const u32x2 gp = *(const u32x2*)(Z + row * LDZ + C_GP + 2 * 512 + c);
    u32x2 o;
    o.x = pack2((hc[mt][0] - mu) * rs * hg.x * siluf_(bflo(gp.x)), (hc[mt][1] - mu) * rs * hg.y * siluf_(bfhi(gp.x)));
    o.y = pack2((hc[mt][2] - mu) * rs * hg.z * siluf_(bflo(gp.y)), (hc[mt][3] - mu) * rs * hg.w * siluf_(bfhi(gp.y)));
    *(u32x2*)(GATED + row * LDG + 1024 + c) = o;
  }
}

template <int N1>
DI void unit_fft1(const Params& p, const SB& sb, int u, unsigned char* smem) {
  constexpr int N2 = N1;
  constexpr int LDU = N1 + 8;
  constexpr int MTW = N1 / 64;
  const u16* Z = (const u16*)(p.ws + OFF_Z);
  const u16* DFT = (const u16*)(p.ws + OFF_DFT);
  const u16* DC128 = DFT, *DS128 = DFT + 16384;
  const u16* DC1 = (N1 == 128) ? DFT : DFT + 32768;
  const u16* DS1 = (N1 == 128) ? DFT + 16384 : DFT + 36864;
  u16* HR = (u16*)(p.ws + OFF_OUT);
  u16* HI = HR + (size_t)MTOK * 512;
  u16* sX = (u16*)smem;
  u16* sUT = sX + 128 * 136;
  u16* sVT = sUT + 64 * 136;
  const int tid = TIDX(), lane = tid & 63, w = tid >> 6;
  const int qh = u & 1, g4 = (u >> 1) & 3; int t2 = u >> 3; const int n2 = t2 % N2, b = t2 / N2;
  const int L = sb.L;
  __syncthreads();
  for (int id = tid; id < N1 * 16; id += 256) {
    const int n1 = id >> 4, ch = id & 15;
    *(u32x4*)(sX + n1 * 136 + ch * 8) = *(const u32x4*)(Z + ((size_t)b * L + (size_t)N2 * n1 + n2) * LDZ + C_XB + g4 * 128 + ch * 8);
  }
  __syncthreads();
  {
    f32x4 au[MTW][4], av[MTW][4];
#pragma unroll
    for (int a = 0; a < MTW; ++a)
#pragma unroll
      for (int c = 0; c < 4; ++c) { au[a][c] = f32x4{0.f, 0.f, 0.f, 0.f}; av[a][c] = f32x4{0.f, 0.f, 0.f, 0.f}; }
#pragma unroll
    for (int ks = 0; ks < 4; ++ks) {
      bf16x8 xf[MTW], cf[4], sf[4];
#pragma unroll
      for (int mt = 0; mt < MTW; ++mt) xf[mt] = ldfrag(sX + ((w * MTW + mt) * 16 + (lane & 15)) * 136 + ks * 32 + (lane >> 4) * 8);
#pragma unroll
      for (int nt = 0; nt < 4; ++nt) {
        const int q = qh * 64 + nt * 16 + (lane & 15);
        cf[nt] = ldfrag(DC128 + q * 128 + ks * 32 + (lane >> 4) * 8);
        sf[nt] = ldfrag(DS128 + q * 128 + ks * 32 + (lane >> 4) * 8);
      }
#pragma unroll
      for (int mt = 0; mt < MTW; ++mt)
#pragma unroll
        for (int nt = 0; nt < 4; ++nt) { au[mt][nt] = mfma16(xf[mt], cf[nt], au[mt][nt]); av[mt][nt] = mfma16(xf[mt], sf[nt], av[mt][nt]); }
    }
#pragma unroll
    for (int mt = 0; mt < MTW; ++mt)
#pragma unroll
      for (int nt = 0; nt < 4; ++nt) {
        const int ql = nt * 16 + (lane & 15), n1 = (w * MTW + mt) * 16 + (lane >> 4) * 4;
        u32x2 o; o.x = pack2(au[mt][nt][0], au[mt][nt][1]); o.y = pack2(au[mt][nt][2], au[mt][nt][3]);
        *(u32x2*)(sUT + ql * LDU + n1) = o;
        o.x = pack2(av[mt][nt][0], av[mt][nt][1]); o.y = pack2(av[mt][nt][2], av[mt][nt][3]);
        *(u32x2*)(sVT + ql * LDU + n1) = o;
      }
  }
  __syncthreads();
  f32x4 gr[MTW][4], gi[MTW][4];
#pragma unroll
  for (int a = 0; a < MTW; ++a)
#pragma unroll
    for (int c = 0; c < 4; ++c) { gr[a][c] = f32x4{0.f, 0.f, 0.f, 0.f}; gi[a][c] = f32x4{0.f, 0.f, 0.f, 0.f}; }
#pragma unroll
  for (int ks = 0; ks < N1 / 32; ++ks) {
    bf16x8 uf[4], vf[4];
#pragma unroll
    for (int nt = 0; nt < 4; ++nt) {
      uf[nt] = ldfrag(sUT + (nt * 16 + (lane & 15)) * LDU + ks * 32 + (lane >> 4) * 8);
      vf[nt] = ldfrag(sVT + (nt * 16 + (lane & 15)) * LDU + ks * 32 + (lane >> 4) * 8);
    }
#pragma unroll
    for (int mt = 0; mt < MTW; ++mt) {
      const int k1 = (w * MTW + mt) * 16 + (lane & 15);
      const bf16x8 cf = ldfrag(DC1 + k1 * N1 + ks * 32 + (lane >> 4) * 8);
      const bf16x8 sf = ldfrag(DS1 + k1 * N1 + ks * 32 + (lane >> 4) * 8);
      const bf16x8 sn = negfrag(sf);
#pragma unroll
      for (int nt = 0; nt < 4; ++nt) {
        gr[mt][nt] = mfma16(uf[nt], cf, gr[mt][nt]);
        gr[mt][nt] = mfma16(vf[nt], sn, gr[mt][nt]);
        gi[mt][nt] = mfma16(uf[nt], sf, gi[mt][nt]);
        gi[mt][nt] = mfma16(vf[nt], cf, gi[mt][nt]);
      }
    }
  }
  const float sc = rsqrtf((float)(N1 * 128));
#pragma unroll
  for (int mt = 0; mt < MTW; ++mt) {
    const int k1 = (w * MTW + mt) * 16 + (lane & 15);
    const float ang = 2.f * (float)((n2 * k1) % L) / (float)L;
    const float cph = __builtin_amdgcn_cosf(0.5f * ang) * sc, sph = __builtin_amdgcn_sinf(0.5f * ang) * sc;
    const size_t base = (((size_t)b * N1 + k1) * N2 + n2) * 512 + g4 * 128 + qh * 64;
#pragma unroll
    for (int nt = 0; nt < 4; ++nt) {
      float hr[4], hi[4];
#pragma unroll
      for (int i = 0; i < 4; ++i) { hr[i] = gr[mt][nt][i] * cph - gi[mt][nt][i] * sph; hi[i] = gr[mt][nt][i] * sph + gi[mt][nt][i] * cph; }
      u32x2 o; o.x = pack2(hr[0], hr[1]); o.y = pack2(hr[2], hr[3]);
      *(u32x2*)(HR + base + nt * 16 + (lane >> 4) * 4) = o;
      o.x = pack2(hi[0], hi[1]); o.y = pack2(hi[2], hi[3]);
      *(u32x2*)(HI + base + nt * 16 + (lane >> 4) * 4) = o;
    }
  }
}

template <int N2>
DI void unit_fft2(const Params& p, const SB& sb, int u, unsigned char* smem) {
  constexpr int N1 = N2;
  constexpr int LDH = N2 + 8;
  constexpr int MTW = N2 / 64;
  const u16* Z = (const u16*)(p.ws + OFF_Z);
  const u16* DFT = (const u16*)(p.ws + OFF_DFT);
  const u16* DC2 = (N2 == 128) ? DFT : DFT + 32768;
  const u16* DS2 = (N2 == 128) ? DFT + 16384 : DFT + 36864;
  const u16* HR = (const u16*)(p.ws + OFF_OUT);
  const u16* HI = HR + (size_t)MTOK * 512;
  u16* GATED = (u16*)(p.ws + OFF_GATED);
  u16* sHr = (u16*)smem;
  u16* sHi = sHr + 128 * 136;
  const int tid = TIDX(), lane = tid & 63, w = tid >> 6;
  const int g4 = u & 3; int t2 = u >> 2; const int k1 = t2 % N1, b = t2 / N1;
  const int L = sb.L;
  __syncthreads();
  for (int id = tid; id < N2 * 16; id += 256) {
    const int n2 = id % N2, ch = id / N2;
    const size_t src = (((size_t)b * N1 + k1) * N2 + n2) * 512 + g4 * 128 + ch * 8;
    const u32x4 a = *(const u32x4*)(HR + src);
    const u32x4 c = *(const u32x4*)(HI + src);
    const unsigned aw[4] = {a.x, a.y, a.z, a.w}, cw[4] = {c.x, c.y, c.z, c.w};
#pragma unroll
    for (int e = 0; e < 8; ++e) {
      sHr[(ch * 8 + e) * LDH + n2] = (u16)((e & 1) ? (aw[e >> 1] >> 16) : (aw[e >> 1] & 0xffff));
      sHi[(ch * 8 + e) * LDH + n2] = (u16)((e & 1) ? (cw[e >> 1] >> 16) : (cw[e >> 1] & 0xffff));
    }
  }
  __syncthreads();
  f32x4 acc[MTW][8];
#pragma unroll
  for (int a = 0; a < MTW; ++a)
#pragma unroll
    for (int c = 0; c < 8; ++c) acc[a][c] = f32x4{0.f, 0.f, 0.f, 0.f};
#pragma unroll
  for (int ks = 0; ks < N2 / 32; ++ks) {
    bf16x8 cf[MTW], sn[MTW];
#pragma unroll
    for (int mt = 0; mt < MTW; ++mt) {
      const int k2 = (w * MTW + mt) * 16 + (lane & 15);
      cf[mt] = ldfrag(DC2 + k2 * N2 + ks * 32 + (lane >> 4) * 8);
      sn[mt] = negfrag(ldfrag(DS2 + k2 * N2 + ks * 32 + (lane >> 4) * 8));
    }
#pragma unroll
    for (int nt = 0; nt < 8; ++nt) {
      const bf16x8 hr = ldfrag(sHr + (nt * 16 + (lane & 15)) * LDH + ks * 32 + (lane >> 4) * 8);
      const bf16x8 hi = ldfrag(sHi + (nt * 16 + (lane & 15)) * LDH + ks * 32 + (lane >> 4) * 8);
#pragma unroll
      for (int mt = 0; mt < MTW; ++mt) { acc[mt][nt] = mfma16(hr, cf[mt], acc[mt][nt]); acc[mt][nt] = mfma16(hi, sn[mt], acc[mt][nt]); }
    }
  }
  const float sc = rsqrtf((float)N2);
#pragma unroll
  for (int mt = 0; mt < MTW; ++mt) {
    const int k2 = (w * MTW + mt) * 16 + (lane & 15);
    const size_t row = (size_t)b * L + (size_t)k1 + (size_t)N1 * k2;
#pragma unroll
    for (int nt = 0; nt < 8; ++nt) {
      const int c = g4 * 128 + nt * 16 + (lane >> 4) * 4;
      const u32x2 gp = *(const u32x2*)(Z + row * LDZ + C_GP + 512 + c);
      u32x2 o;
      o.x = pack2(acc[mt][nt][0] * sc * siluf_(bflo(gp.x)), acc[mt][nt][1] * sc * siluf_(bfhi(gp.x)));
      o.y = pack2(acc[mt][nt][2] * sc * siluf_(bflo(gp.y)), acc[mt][nt][3] * sc * siluf_(bfhi(gp.y)));
      *(u32x2*)(GATED + row * LDG + 512 + c) = o;
    }
  }
}

DI void unit_attn_combine(const Params& p, int u) {
  const u16* Z = (const u16*)(p.ws + OFF_Z);
  const float* LSE = (const float*)(p.ws + OFF_LSE);
  u16* GATED = (u16*)(p.ws + OFF_GATED);
  const int tid = TIDX(), lane = tid & 63, w = tid >> 6;
#pragma unroll 1
  for (int rr = 0; rr < 4; ++rr) {
    const size_t row = (size_t)u * 16 + w * 4 + rr;
    const int c = lane * 8, h = c >> 7;
    const float l0 = LSE[row * 12 + h], l1 = LSE[row * 12 + 4 + h], l2 = LSE[row * 12 + 8 + h];
    const float mx = fmaxf(l0, fmaxf(l1, l2));
    const float e0 = __expf(l0 - mx), e1 = __expf(l1 - mx), e2 = __expf(l2 - mx);
    const float inv = __builtin_amdgcn_rcpf(e0 + e1 + e2);
    float o0[8], o1[8], o2[8], gp[8];
    unpack8(*(const u32x4*)(Z + row * LDZ + C_QA + c), o0);
    unpack8(*(const u32x4*)(Z + row * LDZ + C_QA + 512 + c), o1);
    unpack8(*(const u32x4*)(Z + row * LDZ + C_QA + 1024 + c), o2);
    unpack8(*(const u32x4*)(Z + row * LDZ + C_GP + c), gp);
    float y[8];
#pragma unroll
    for (int e = 0; e < 8; ++e) y[e] = (e0 * o0[e] + e1 * o1[e] + e2 * o2[e]) * inv * siluf_(gp[e]);
    u32x4 o; o.x = pack2(y[0], y[1]); o.y = pack2(y[2], y[3]); o.z = pack2(y[4], y[5]); o.w = pack2(y[6], y[7]);
    *(u32x4*)(GATED + row * LDG + c) = o;
    float dv[8], dg[8];
    unpack8(*(const u32x4*)(GATED + row * LDG + 1536 + c), dv);
    unpack8(*(const u32x4*)(Z + row * LDZ + C_GP + 3 * 512 + c), dg);
    u32x4 od; od.x = pack2(dv[0] * siluf_(dg[0]), dv[1] * siluf_(dg[1])); od.y = pack2(dv[2] * siluf_(dg[2]), dv[3] * siluf_(dg[3]));
    od.z = pack2(dv[4] * siluf_(dg[4]), dv[5] * siluf_(dg[5])); od.w = pack2(dv[6] * siluf_(dg[6]), dv[7] * siluf_(dg[7]));
    *(u32x4*)(GATED + row * LDG + 1536 + c) = od;
  }
}

DI void phase_branchproj(const Params& p, int l, unsigned char* smem_) {
  const u16* Z = (const u16*)(p.ws + OFF_Z);
  const u16* GATED = (const u16*)(p.ws + OFF_GATED);
  const u16* WbT = (const u16*)(p.ws + OFF_WB) + (size_t)l * DM * LDG;
  u16* MERGED = (u16*)(p.ws + OFF_H);
  u16* smem = (u16*)smem_;
  const int tid = TIDX(), lane = tid & 63, w = tid >> 6, wm = w >> 1, wn = w & 1;
  constexpr bool PIPE = false;
  u16* sA = smem;
  u16* sB = smem + 2 * 8192;
  const int lr = tid >> 3, lc = (tid & 7) * 8;
  const int wsw = ((tid & 7) ^ ((lr >> 1) & 7)) * 8;
  const int rg = (lane & 15) >> 1, rq = lane >> 4;
  const int rs0 = (((rg >> 2) * 4) + (rq ^ (rg & 3))) * 8;
  const int rs1 = ((((rg >> 2) ^ 1) * 4) + (rq ^ (rg & 3))) * 8;
  for (int u = VB(); u < 8 * 128; u += VG()) {
    const int nt0 = u / 128, mt0 = u % 128;
    const u16* A = GATED + (size_t)mt0 * 128 * LDG;
    const u16* Bt = WbT + (size_t)nt0 * 128 * LDG;
    const int lda = LDG, ldb = LDG;
    f32x4 mer[4][4], acc[4][4];
    zero_acc(mer);
    zero_acc(acc);
    u32x4 r0a[4], r0b[4];
    G_LOAD(r0a, r0b, 0)
    __syncthreads();
    G_WRITE(r0a, r0b, 0)
    __syncthreads();
#pragma unroll 1
    for (int kt = 0; kt < 32; ++kt) {
      const int buf = kt & 1, g = kt >> 3;
      if (kt + 1 < 32) { G_LOAD(r0a, r0b, (kt + 1) * 64) }
      G_COMPUTE(buf)
      if (kt + 1 < 32) { G_WRITE(r0a, r0b, buf ^ 1) }
      __syncthreads();
      if ((kt & 7) == 7) {
#pragma unroll
        for (int mt = 0; mt < 4; ++mt)
#pragma unroll
          for (int nt = 0; nt < 4; ++nt) {
            const int row = mt0 * 128 + wm * 64 + mt * 16 + (lane & 15);
            const int col = nt0 * 128 + wn * 64 + nt * 16 + (lane >> 4) * 4;
            const u32x2 mg = *(const u32x2*)(Z + (size_t)row * LDZ + C_MG + g * 1024 + col);
            mer[mt][nt][0] += sigmoidf_(bflo(mg.x)) * acc[mt][nt][0];
            mer[mt][nt][1] += sigmoidf_(bfhi(mg.x)) * acc[mt][nt][1];
            mer[mt][nt][2] += sigmoidf_(bflo(mg.y)) * acc[mt][nt][2];
            mer[mt][nt][3] += sigmoidf_(bfhi(mg.y)) * acc[mt][nt][3];
            acc[mt][nt] = f32x4{0.f, 0.f, 0.f, 0.f};
          }
      }
    }
#pragma unroll
    for (int mt = 0; mt < 4; ++mt)
#pragma unroll
      for (int nt = 0; nt < 4; ++nt) {
        const int row = mt0 * 128 + wm * 64 + mt * 16 + (lane & 15);
        const int col = nt0 * 128 + wn * 64 + nt * 16 + (lane >> 4) * 4;
        u32x2 o; o.x = pack2(mer[mt][nt][0], mer[mt][nt][1]); o.y = pack2(mer[mt][nt][2], mer[mt][nt][3]);
        *(u32x2*)(MERGED + (size_t)row * LDH + col) = o;
      }
  }
}

DI void phase_outproj(const Params& p, int l, unsigned char* smem_base) {
  pg8::Gemm g; g.A = (const u16*)(p.ws + OFF_H); g.Bt = (const u16*)(p.ws + OFF_WO) + (size_t)l * DM * LDH; g.M = MTOK; g.N = DM; g.K = DM; g.ld = LDH;
  pg8::StaticOrder S; S.init(MTOK, DM, gridDim.x, blockIdx.x);
  pg8::EpiBf16 E; E.O = (u16*)(p.ws + OFF_OUT); E.ldc = DM;
  pg8::gemm_phase((PG8_LAS unsigned char*)smem_base, g, S, E);
}

DI void mix1_unit(const Params& p, const Bucket& bk, const SB& sb, int l, unsigned char* smem, int dry, int u) {
  const int nF = sb.B * sb.N1 * 8;
  const int nC = (MTOK / 64) * 4;
  const int nD = (MTOK / 64) * 4;
  int v = u;
  if (v < nF) { if (!dry || (PROBE_UNITS & 1)) { if (sb.N1 == 128) unit_fft1<128>(p, sb, v, smem); else unit_fft1<64>(p, sb, v, smem); } return; }
  v -= nF;
  if (v < nC) { if (!dry || (PROBE_UNITS & 2)) unit_mlstm_local(p, sb, l, v, smem); return; }
  v -= nC;
  if (v < nD) { if (!dry || (PROBE_UNITS & 4)) unit_attnD(p, sb, l, v, smem); return; }
  v -= nD;
  if (!dry || (PROBE_UNITS & 8)) unit_attnA(p, bk, sb, v, smem, dry);
}
DI void phase_mix1(const Params& p, const Bucket& bk, const SB& sb, int l, unsigned char* smem, int dry, unsigned* qhead, volatile unsigned* qslot) {
  const int nF = sb.B * sb.N1 * 8;
  const int tot = MTOK * 12 / 64 + nF + 2 * (MTOK / 64) * 4;
  if (qhead == nullptr) {
    for (int u = VB(); u < tot; u += VG()) mix1_unit(p, bk, sb, l, smem, dry, u);
    return;
  }
  const int half = HALF_ID();
  if (threadIdx.x == 0) *qslot = xb_add(qhead, 1u);
  __syncthreads();
  for (;;) {
    const int k = (int)*qslot;
    if (2 * k >= tot) break;
    unsigned nxt = 0u;
    if (threadIdx.x == 0) nxt = xb_add(qhead, 1u);
    const int pos = 2 * k + half;
    const int u = (pos < tot - nF) ? pos + nF : pos - (tot - nF);
    mix1_unit(p, bk, sb, l, smem, dry, u);
    __syncthreads();
    if (threadIdx.x == 0) *qslot = nxt;
    __syncthreads();
  }
}
DI void mix2_unit(const Params& p, const SB& sb, unsigned char* smem, int dry, int u) {
  const int nS = sb.B * 8 * 32, nA = MTOK / 16;
  int v = u;
  if (v < nS) { unit_mlstm_scan(p, sb, v, smem, dry); return; }
  v -= nS;
  if (v < nA) { unit_attn_combine(p, v); return; }
  v -= nA;
  if (sb.N1 == 128) unit_fft2<128>(p, sb, v, smem); else unit_fft2<64>(p, sb, v, smem);
}
DI void phase_mix2(const Params& p, const SB& sb, int l, unsigned char* smem, int dry, unsigned* qhead, volatile unsigned* qslot) {
  const int nF = sb.B * sb.N1 * 4;
  const int nS = sb.B * 8 * 32;
  const int nA = MTOK / 16;
  const int tot = nF + nS + nA;
  if (qhead == nullptr) {
    for (int u = VB(); u < tot; u += VG()) mix2_unit(p, sb, smem, dry, u);
    return;
  }
  const int half = HALF_ID();
  if (threadIdx.x == 0) *qslot = xb_add(qhead, 1u);
  __syncthreads();
  for (;;) {
    const int k = (int)*qslot;
    if (2 * k >= tot) break;
    unsigned nxt = 0u;
    if (threadIdx.x == 0) nxt = xb_add(qhead, 1u);
    const int pos = 2 * k + half;
    const int u = (pos < nS) ? pos : (pos < nS + nF ? pos + nA : pos - nF);
    mix2_unit(p, sb, smem, dry, u);
    __syncthreads();
    if (threadIdx.x == 0) *qslot = nxt;
    __syncthreads();
  }
}
DI void phase_mix3(const Params& p, const SB& sb, int l, unsigned char* smem) {
  const int nC = (MTOK / 64) * 4;
  for (int u = VB(); u < nC; u += VG()) unit_mlstm_out(p, sb, l, u, smem);
}

constexpr int STEPS_PER_SB = 4 * 7 + 1;
constexpr int N_STEPS = 2 + 3 * STEPS_PER_SB;

DI void run_step(const Params& p0, const Bucket& bk, int s, unsigned char* smem_base, int dry, bool coop, volatile unsigned* qslot) {
  Params p = p0;
  asm volatile("" : "+s"(p.ws));
  unsigned char* smem = smem_base + HALF_ID() * SMEM_HALF;
  if (s == 0) { phase_prep0(p, bk, smem); return; }
  int sbi, l, ph;
  if (coop) {
    if (s == 1) { phase_prep1(p, smem); const SB sb0 = get_sb(p, 0); phase_rows(p, sb0, 0, dry); return; }
    const int s2 = s - 2, r = s2 % 28; sbi = s2 / 28;
    if (r == 27) {
      const SB sbx = get_sb(p, sbi); phase_rows(p, sbx, 4, dry);
      if (sbi < 2) { const SB sbn = get_sb(p, sbi + 1); phase_rows(p, sbn, 0, dry); }
      return;
    }
    if (r < 6) { l = 0; ph = r + 1; } else { const int q = r - 6; l = 1 + q / 7; ph = q % 7; }
  } else {
    if (s == 1) { phase_prep1(p, smem); return; }
    const int s2 = s - 2, r = s2 % STEPS_PER_SB; sbi = s2 / STEPS_PER_SB;
    if (r == 28) { const SB sbx = get_sb(p, sbi); phase_rows(p, sbx, 4, dry); return; }
    l = r / 7; ph = r % 7;
  }
  const SB sb = get_sb(p, sbi);
  switch (ph) {
    case 0: phase_rows(p, sb, l, dry); break;
    case 1: phase_inproj(p, l, smem_base); break;
    case 2: phase_mix1(p, bk, sb, l, smem, dry, coop ? (unsigned*)(p.ws + OFF_BAR) + 4096 + (s & 127) : nullptr, qslot); break;
    case 3: phase_mix2(p, sb, l, smem, dry, coop ? (unsigned*)(p.ws + OFF_BAR) + 4096 + (s & 127) : nullptr, qslot); break;
    case 4: phase_mix3(p, sb, l, smem); break;
    case 5: phase_branchproj(p, l, smem); break;
    default: phase_outproj(p, l, smem_base); break;
  }
}

__global__ void __launch_bounds__(512, 2) mega_step(Params p, Bucket bk, int s, int dry) {
  extern __shared__ __attribute__((aligned(16))) unsigned char smem[];
  run_step(p, bk, s, smem, dry, false, nullptr);
}

__global__ void __launch_bounds__(512, 2) mega_coop(Params p, Bucket bk) {
  extern __shared__ __attribute__((aligned(16))) unsigned char smem[];
  __shared__ uint4 xb_words;
  cg::grid_group grid = cg::this_grid();
  if (p.ws == nullptr) grid.sync();
  if (threadIdx.x == 0) xb_words = make_uint4(0u, 0u, 0u, 0u);
  __syncthreads();
  (void)xcd_barrier_post((unsigned*)(p.ws + OFF_BAR), (volatile LAS unsigned*)&xb_words);
  constexpr int N_STEPS_COOP = 2 + 3 * 28;
#pragma unroll 1
  for (int s = 0; s < N_STEPS_COOP; ++s) {
    run_step(p, bk, s, smem, 0, true, (volatile unsigned*)&xb_words + 2);
    if (s + 1 < N_STEPS_COOP) {
      XcdBarrier xb; xb.bar = (unsigned*)(p.ws + OFF_BAR); xb.x = xb_xcc_id(); xb.st = (volatile LAS unsigned*)&xb_words;
      xcd_barrier(xb);
    }
  }
}

static int t5_bucket_host(int rel) {
  const int nb = 16, max_exact = 8;
  int ret = (rel > 0) ? nb : 0;
  int n = rel < 0 ? -rel : rel;
  int nn = n > 1 ? n : 1;
  int large = max_exact + (int)(std::log((double)nn / max_exact) / std::log(1024.0 / max_exact) * (nb - max_exact));
  if (large > nb - 1) large = nb - 1;
  return ret + (n < max_exact ? n : large);
}

extern "C" void kernel_launch(void* const* d_in, const int* in_sizes, int n_in, void* d_out, int out_size, void* d_ws,
                              size_t ws_size, hipStream_t stream) {
  Params p;
  memset(&p, 0, sizeof(p));
  p.x_prompt = (const float*)d_in[0]; p.x_sample = (const float*)d_in[1];
  p.mem_prompt = (const float*)d_in[2]; p.mem_sample = (const float*)d_in[3];
  p.rel_bias = (const float*)d_in[4]; p.norm_pre = (const float*)d_in[5]; p.w_in = (const float*)d_in[6];
  p.conv_qk = (const float*)d_in[7]; p.gate_bias = (const float*)d_in[8]; p.head_gain = (const float*)d_in[9];
  p.mem_norm = (const float*)d_in[10]; p.w_mem_kv = (const float*)d_in[11]; p.w_branch = (const float*)d_in[12];
  p.w_out = (const float*)d_in[13]; p.norm_post = (const float*)d_in[14];
  p.out = (float*)d_out;
  p.ws = (unsigned char*)d_ws;
  Bucket bk;
  memset(&bk, 0, sizeof(bk));
  const int dil[3] = {1, 4, 16};
  for (int g = 0; g < 3; ++g)
    for (int i = 0; i < 129; ++i) bk.b[g][i] = (unsigned char)t5_bucket_host(dil[g] * (i - 64));
  if (ws_size < WS_NEED) fprintf(stderr, "workspace too small: %zu < %zu\n", ws_size, (size_t)WS_NEED);

  static int grid_blocks = 0;
  if (!grid_blocks) {
    int dev = 0, cus = 0, per_cu = 0;
    hipGetDevice(&dev);
    hipDeviceGetAttribute(&cus, hipDeviceAttributeMultiprocessorCount, dev);
    hipFuncSetAttribute((const void*)mega_step, hipFuncAttributeMaxDynamicSharedMemorySize, SMEM_BYTES);
    hipFuncSetAttribute((const void*)mega_coop, hipFuncAttributeMaxDynamicSharedMemorySize, SMEM_BYTES);
    hipOccupancyMaxActiveBlocksPerMultiprocessor(&per_cu, mega_coop, 512, SMEM_BYTES);
    if (per_cu < 1) per_cu = 1;
    if (per_cu > 1) per_cu = 1;
    grid_blocks = cus * per_cu;
  }
#if MK_COOP
  hipMemsetAsync((unsigned char*)d_ws + OFF_BAR, 0, (4096 + 128) * sizeof(unsigned), stream);
  void* args[] = {&p, &bk};
  hipError_t e = hipLaunchCooperativeKernel((void*)mega_coop, dim3(grid_blocks), dim3(512), args, SMEM_BYTES, stream);
  if (e != hipSuccess) fprintf(stderr, "cooperative launch failed: %s (grid %d)\n", hipGetErrorString(e), grid_blocks);
#else
  for (int s = 0; s < N_STEPS; ++s) {
    if (PROBE_REPEAT > 0 && s >= 2 && ((s - 2) % STEPS_PER_SB) != 28 && ((PROBE_REPEAT >> (((s - 2) % STEPS_PER_SB) % 7)) & 1))
      hipLaunchKernelGGL(mega_step, dim3(grid_blocks), dim3(512), SMEM_BYTES, stream, p, bk, s, 1);
    hipLaunchKernelGGL(mega_step, dim3(grid_blocks), dim3(512), SMEM_BYTES, stream, p, bk, s, 0);
  }
#endif
}
```
